# Optimizing an MI355X kernel written in HIP

```python
import math
import jax, jax.numpy as jnp
from jax import lax
import numpy as np

D_MODEL = 1024
BATCH = 8
SEQ = 2048
DEPTH = 2

CHUNK = 64
Q_BLOCK = 128
N_MIXERS = 2
DA_HEAD_DIM = 64
DA_HEADS = D_MODEL // (2 * DA_HEAD_DIM)
SB_HEAD_DIM = 64
SB_HEADS = D_MODEL // SB_HEAD_DIM
D_FF = 2816
PLE_DIM = 256
N_NORMS = 8
EPS = 1e-6
NEG_BIG = -1e30

kernel_name = "hybrid_diffattn_stickbreaking_macaron_trunk"


def rmsnorm(x, g):
    xf = x.astype(jnp.float32)
    y = xf * lax.rsqrt(jnp.mean(xf * xf, axis=-1, keepdims=True) + EPS)
    return (y * g.astype(jnp.float32)).astype(x.dtype)


def swiglu(h, w_in, w_out):
    a, b = jnp.split(h @ w_in, 2, axis=-1)
    return (jax.nn.silu(a) * b) @ w_out


def alibi_slopes(n_heads):
    return jnp.asarray([2.0 ** (-8.0 * (h + 1) / n_heads) for h in range(n_heads)], dtype=jnp.float32)


def diff_attention(h, w_qkv, w_o, lam_vecs, subln_g, lambda_init):
    B, S, _ = h.shape
    H, d = DA_HEADS, DA_HEAD_DIM
    q, k, v = jnp.split(h @ w_qkv, 3, axis=-1)
    q = q.reshape(B, S, H, 2, d)
    k = k.reshape(B, S, H, 2, d)
    v = v.reshape(B, S, H, 2 * d)
    lv = lam_vecs.astype(jnp.float32)
    lam = jnp.exp(jnp.sum(lv[0] * lv[1])) - jnp.exp(jnp.sum(lv[2] * lv[3])) + lambda_init
    slopes = alibi_slopes(H)
    scale = 1.0 / math.sqrt(d)
    outs = []
    for blk in range(S // Q_BLOCK):
        q0, end = blk * Q_BLOCK, (blk + 1) * Q_BLOCK
        qb, kb, vb = q[:, q0:end], k[:, :end], v[:, :end]
        s = jnp.einsum('bqhcd,bkhcd->bchqk', qb, kb).astype(jnp.float32) * scale
        tq = jnp.arange(q0, end)
        tk = jnp.arange(end)
        dist = jnp.abs(tq[:, None] - tk[None, :]).astype(jnp.float32)
        bias = -slopes[:, None, None] * dist
        allowed = (tk // CHUNK)[None, :] <= (tq // CHUNK)[:, None]
        s = jnp.where(allowed, s + bias, NEG_BIG)
        pr = jax.nn.softmax(s, axis=-1)
        a = pr[:, 0] - lam * pr[:, 1]
        outs.append(jnp.einsum('bhqk,bkhe->bqhe', a.astype(vb.dtype), vb))
    o = jnp.concatenate(outs, axis=1)
    o = rmsnorm(o, subln_g) * (1.0 - lambda_init)
    return o.reshape(B, S, H * 2 * d) @ w_o


def stick_breaking_attention(h, w_qkv, w_o):
    B, S, _ = h.shape
    H, d = SB_HEADS, SB_HEAD_DIM
    q, k, v = jnp.split(h @ w_qkv, 3, axis=-1)
    q = q.reshape(B, S, H, d)
    k = k.reshape(B, S, H, d)
    v = v.reshape(B, S, H, d)
    scale = 1.0 / math.sqrt(d)
    outs = []
    for blk in range(S // Q_BLOCK):
        q0, end = blk * Q_BLOCK, (blk + 1) * Q_BLOCK
        qb, kb, vb = q[:, q0:end], k[:, :end], v[:, :end]
        z = jnp.einsum('bqhd,bkhd->bhqk', qb, kb).astype(jnp.float32) * scale
        tq = jnp.arange(q0, end)
        tk = jnp.arange(end)
        strict = tk[None, :] < tq[:, None]
        log_not = jnp.where(strict, jax.nn.log_sigmoid(-z), 0.0)
        suffix = lax.cumsum(log_not, axis=3, reverse=True) - log_not
        log_a = jax.nn.log_sigmoid(z) + suffix
        a = jnp.where(strict, jnp.exp(log_a), 0.0)
        outs.append(jnp.einsum('bhqk,bkhd->bqhd', a.astype(vb.dtype), vb))
    o = jnp.concatenate(outs, axis=1)
    return o.reshape(B, S, H * d) @ w_o


def setup_inputs(seed: int = 0) -> dict:
    key = jax.random.key(seed)
    ks = jax.random.split(key, 16)
    n_a = (DEPTH + 1) // 2
    n_b = DEPTH // 2
    D, F = D_MODEL, D_FF
    nrm = jax.random.normal
    x = nrm(ks[0], (BATCH, SEQ, D), jnp.float32)
    p = nrm(ks[1], (DEPTH, BATCH, SEQ, PLE_DIM), jnp.float32)
    norm_gains = 1.0 + 0.05 * nrm(ks[2], (DEPTH, N_NORMS, D), jnp.float32)
    ffn1_w_in = nrm(ks[3], (DEPTH, D, 2 * F), jnp.float32) * D ** -0.5
    ffn1_w_out = nrm(ks[4], (DEPTH, F, D), jnp.float32) * F ** -0.5
    ffn2_w_in = nrm(ks[5], (DEPTH, D, 2 * F), jnp.float32) * D ** -0.5
    ffn2_w_out = nrm(ks[6], (DEPTH, F, D), jnp.float32) * F ** -0.5
    da_w_qkv = nrm(ks[7], (n_a, D, 3 * D), jnp.float32) * D ** -0.5
    da_w_o = nrm(ks[8], (n_a, D, D), jnp.float32) * D ** -0.5
    da_lambda = 0.1 * nrm(ks[9], (n_a, 4, DA_HEAD_DIM), jnp.float32)
    da_subln = 1.0 + 0.05 * nrm(ks[10], (n_a, 2 * DA_HEAD_DIM), jnp.float32)
    sb_w_qkv = nrm(ks[11], (n_b, D, 3 * D), jnp.float32) * D ** -0.5
    sb_w_o = nrm(ks[12], (n_b, D, D), jnp.float32) * D ** -0.5
    ple_w_proj = nrm(ks[13], (DEPTH, PLE_DIM, D), jnp.float32) * PLE_DIM ** -0.5
    ple_w_gate = nrm(ks[14], (DEPTH, D, D), jnp.float32) * D ** -0.5
    return {"x": x, "p": p, "norm_gains": norm_gains,
            "ffn1_w_in": ffn1_w_in, "ffn1_w_out": ffn1_w_out,
            "ffn2_w_in": ffn2_w_in, "ffn2_w_out": ffn2_w_out,
            "da_w_qkv": da_w_qkv, "da_w_o": da_w_o, "da_lambda": da_lambda, "da_subln": da_subln,
            "sb_w_qkv": sb_w_qkv, "sb_w_o": sb_w_o,
            "ple_w_proj": ple_w_proj, "ple_w_gate": ple_w_gate}


def reference(x, p, norm_gains, ffn1_w_in, ffn1_w_out, ffn2_w_in, ffn2_w_out,
              da_w_qkv, da_w_o, da_lambda, da_subln, sb_w_qkv, sb_w_o,
              ple_w_proj, ple_w_gate):
    for i in range(DEPTH):
        g = norm_gains[i]
        x = x + 0.5 * rmsnorm(swiglu(rmsnorm(x, g[0]), ffn1_w_in[i], ffn1_w_out[i]), g[1])
        h = rmsnorm(x, g[2])
        j = i // N_MIXERS
        if i % N_MIXERS == 0:
            lambda_init = 0.8 - 0.6 * math.exp(-0.3 * i)
            m = diff_attention(h, da_w_qkv[j], da_w_o[j], da_lambda[j], da_subln[j], lambda_init)
        else:
            m = stick_breaking_attention(h, sb_w_qkv[j], sb_w_o[j])
        x = x + rmsnorm(m, g[3])
        x = x + 0.5 * rmsnorm(swiglu(rmsnorm(x, g[4]), ffn2_w_in[i], ffn2_w_out[i]), g[5])
        e = p[i] @ ple_w_proj[i]
        gate = jax.nn.sigmoid(rmsnorm(x, g[6]) @ ple_w_gate[i])
        x = x + rmsnorm(gate * e, g[7])
    return x
```

```cpp
#include <hip/hip_runtime.h>
#include <cstdio>
#include <cstdint>
namespace pg8 {
#define PG8_LAS __attribute__((address_space(3)))
typedef unsigned short bf16_t;
typedef short bf16x8 __attribute__((ext_vector_type(8)));
typedef float f32x4 __attribute__((ext_vector_type(4)));
typedef unsigned u32x4 __attribute__((ext_vector_type(4)));
constexpr int BM = 256, BK = 64, HALF = 128, HTB = HALF * BK * 2  , STAGE_BYTES = 8 * HTB, NXCD = 8, WGM = 8;

__host__ __device__ __forceinline__ int lds_byte(int r, int c) { const int st = (r >> 4) * 2 + (c >> 5), rr = r & 15, cc = c & 31, ob = rr * 64 + cc * 2; return st * 1024 + (ob ^ (((ob >> 9) & 1) << 5)); }
__host__ __device__ __forceinline__ void stage_rc(int b, int& R, int& C) { const int st = b / 1024, sb = b % 1024, swz = sb ^ (((sb >> 9) & 1) << 5); R = (st >> 1) * 16 + swz / 64; C = (st & 1) * 32 + (swz % 64) / 2; }
__host__ __device__ __forceinline__ int perm32(int rho) { const int n = rho >> 4, i = rho & 15; return 8 * (i >> 2) + 4 * n + (i & 3); }

struct Unit { int pm, pn; };
struct Gemm { const bf16_t* A; const bf16_t* Bt; int M, N, K; };

struct StaticOrder {
    int nM, nN, nwg, G, c;
    __host__ __device__ void init(int M, int N, int G_, int c_) { nM = M / BM; nN = N / BM; nwg = nM * nN; G = G_; c = c_; }
    __host__ __device__ bool next(int i, Unit& u) const {
        const long L = (long)i * G + c; if (L >= nwg) return false;
        int wgid = (int)L; { const int q = nwg / NXCD, r = nwg % NXCD, xcd = wgid % NXCD, off = wgid / NXCD; wgid = (xcd < r ? xcd * (q + 1) : r * (q + 1) + (xcd - r) * q) + off; }
        const int nig = WGM * nN, gid = wgid / nig, fm = gid * WGM, gsz = (nM - fm) < WGM ? (nM - fm) : WGM;
        u.pm = fm + ((wgid % nig) % gsz); u.pn = (wgid % nig) / gsz; return true;
    }
    __device__ __forceinline__ void a_ready(const Unit&) const {}
    __device__ __forceinline__ void done(const Unit&) const {}
};

__device__ __forceinline__ unsigned cvt_pk_bf16(float lo, float hi) { unsigned r; asm volatile("v_cvt_pk_bf16_f32 %0, %1, %2" : "=v"(r) : "v"(lo), "v"(hi)); return r; }
typedef float f32x2 __attribute__((ext_vector_type(2)));
__device__ __forceinline__ f32x2 gelu_pk(f32x2 v) {
    const f32x2 av = __builtin_elementwise_abs(v), d = av * 0.2316418882f + 1.0f;
    f32x2 t; t.x = __builtin_amdgcn_rcpf(d.x); t.y = __builtin_amdgcn_rcpf(d.y);
    f32x2 q = t * 0.5307027145f + (-0.7265760135f); q = q * t + 0.7107068705f; q = q * t + (-0.142248368f); q = q * t + 0.127414796f; q = q * t;
    const f32x2 s = (v * v) * (-0.72134752044f);
    f32x2 e; e.x = __builtin_amdgcn_exp2f(s.x); e.y = __builtin_amdgcn_exp2f(s.y);
    const f32x2 m = v * (q * e), r = v - m;
    f32x2 o; o.x = v.x < 0.f ? m.x : r.x; o.y = v.y < 0.f ? m.y : r.y; return o;
}

template <int ACT  > struct EpiBf16 {
    static constexpr bool PERM = true, AFTER_DRAIN = false; static_assert(ACT == 0 || ACT == 1, "EpiBf16: ACT is 0 (none) or 1 (gelu_pk)");
    bf16_t* O; int ldc; const float* bias; int split_cols; size_t split_stride; float scale0;
    __device__ __forceinline__ void operator()(const f32x4 (&acc)[2][2][4][2], const Unit& u, int wr, int wc, int fr, int fq) const {
        const int row0 = u.pm * BM + wr * 64 + fr; int colt = u.pn * BM; bf16_t* base = O;
        float sc = 1.f; if (split_cols) { const int t = colt / split_cols; base += (size_t)t * split_stride; colt -= t * split_cols; if (t == 0) sc = scale0; }
        const int col0 = colt + wc * 32 + 8 * fq, bcol0 = u.pn * BM + wc * 32 + 8 * fq;
        f32x4 bv[2][2];
#pragma unroll
        for (int bj = 0; bj < 2; ++bj)
#pragma unroll
            for (int n = 0; n < 2; ++n) bv[bj][n] = bias ? *(const f32x4*)(bias + bcol0 + bj * HALF + 4 * n) : (f32x4){0.f, 0.f, 0.f, 0.f};
#pragma unroll
        for (int ai = 0; ai < 2; ++ai)
#pragma unroll
            for (int m = 0; m < 4; ++m) { bf16_t* rowp = base + (size_t)(row0 + ai * HALF + m * 16) * ldc + col0;
#pragma unroll
                for (int bj = 0; bj < 2; ++bj) { f32x4 v0 = acc[ai][bj][m][0] + bv[bj][0], v1 = acc[ai][bj][m][1] + bv[bj][1];
                    if (ACT == 1) { f32x2 a = gelu_pk((f32x2){v0[0], v0[1]}), b = gelu_pk((f32x2){v0[2], v0[3]}), c = gelu_pk((f32x2){v1[0], v1[1]}), d = gelu_pk((f32x2){v1[2], v1[3]});
                        v0 = (f32x4){a.x, a.y, b.x, b.y}; v1 = (f32x4){c.x, c.y, d.x, d.y}; }
                    v0 = v0 * sc; v1 = v1 * sc; u32x4 w; w.x = cvt_pk_bf16(v0[0], v0[1]); w.y = cvt_pk_bf16(v0[2], v0[3]); w.z = cvt_pk_bf16(v1[0], v1[1]); w.w = cvt_pk_bf16(v1[2], v1[3]);
                    *(u32x4*)(rowp + bj * HALF) = w; } }
    }
};

struct PanelStats {
    unsigned* xbuf;
    unsigned* cnt;
    unsigned* tmo;
    int ntn; float eps;
    unsigned code;
    __device__ __forceinline__ bool run(const f32x4 (&v)[2][2][4][2], const Unit& u, int wr, int wc, int fr, int fq, PG8_LAS unsigned char* lds, int wid, int lane) const {
        typedef float f32x2v __attribute__((ext_vector_type(2)));
        PG8_LAS f32x2v* P = (PG8_LAS f32x2v*)lds;
        PG8_LAS f32x2v* S = (PG8_LAS f32x2v*)(lds + 8192);
        PG8_LAS unsigned* flag = (PG8_LAS unsigned*)(lds + 8192 + 2048);
#pragma unroll
        for (int ai = 0; ai < 2; ++ai)
#pragma unroll
            for (int m = 0; m < 4; ++m) {
                float s = 0.f;
#pragma unroll
                for (int bj = 0; bj < 2; ++bj)
#pragma unroll
                    for (int n = 0; n < 2; ++n) { const f32x4 x = v[ai][bj][m][n]; s += (x[0] + x[1]) + (x[2] + x[3]); }
                s += __shfl_xor(s, 16); s += __shfl_xor(s, 32);
                const float mw = s * (1.0f / 64.0f); float q = 0.f;
#pragma unroll
                for (int bj = 0; bj < 2; ++bj)
#pragma unroll
                    for (int n = 0; n < 2; ++n) { const f32x4 d = v[ai][bj][m][n] - mw; q += (d[0] * d[0] + d[1] * d[1]) + (d[2] * d[2] + d[3] * d[3]); }
                q += __shfl_xor(q, 16); q += __shfl_xor(q, 32);
                if (fq == 0) P[(ai * HALF + wr * 64 + m * 16 + fr) * 4 + wc] = (f32x2v){mw, q};
            }
        asm volatile("s_waitcnt lgkmcnt(0)" ::: "memory"); __builtin_amdgcn_s_barrier(); asm volatile("" ::: "memory");
#if defined(BROKEN_EXCHANGE_NO_WAIT)
#warning BROKEN CONTROL BUILD: the row-statistics exchange does not wait; results are wrong by design
        if (blockIdx.x >= 64) { const long long t0_ = clock64(); while (clock64() - t0_ < 60000) __builtin_amdgcn_s_sleep(8); }
#endif
        const int row = wid * 32 + (lane & 31);
        if (lane < 32) {
            const f32x2v a = P[row * 4 + 0], b = P[row * 4 + 1], c = P[row * 4 + 2], d = P[row * 4 + 3];
            const float mt = (a.x + b.x + c.x + d.x) * 0.25f;
            const float da = a.x - mt, db = b.x - mt, dc = c.x - mt, dd = d.x - mt;
            const float m2 = (a.y + b.y) + (c.y + d.y) + 64.0f * ((da * da + db * db) + (dc * dc + dd * dd));
            unsigned long long* slot = (unsigned long long*)xbuf + ((size_t)(u.pm * BM + row) * 4 + u.pn);
            __hip_atomic_store(slot, ((unsigned long long)__float_as_uint(m2) << 32) | __float_as_uint(mt), __ATOMIC_RELAXED, __HIP_MEMORY_SCOPE_AGENT);
        }
        asm volatile("s_waitcnt vmcnt(0)" ::: "memory");
        if (lane == 0) __hip_atomic_fetch_add(cnt + 64 * u.pm, 1u, __ATOMIC_RELAXED, __HIP_MEMORY_SCOPE_AGENT);
        if (wid == 0) {
            bool dead = false; const unsigned long long t0 = __builtin_amdgcn_s_memrealtime(); const unsigned want = 8u * (unsigned)ntn;
            for (;;) {
#if defined(BROKEN_EXCHANGE_NO_WAIT)
                break;
#endif
                if ((unsigned)__builtin_amdgcn_readfirstlane(__hip_atomic_load(cnt + 64 * u.pm, __ATOMIC_RELAXED, __HIP_MEMORY_SCOPE_AGENT)) >= want) break;
                if (__builtin_amdgcn_s_memrealtime() - t0 > 2000000ull) {
                    if (lane == 0) { unsigned expect = 0u; __hip_atomic_compare_exchange_strong(tmo + 1, &expect, code | (unsigned)(u.pm & 0xff), __ATOMIC_RELAXED, __ATOMIC_RELAXED, __HIP_MEMORY_SCOPE_AGENT);
                                     __hip_atomic_store(tmo, 1u, __ATOMIC_RELAXED, __HIP_MEMORY_SCOPE_AGENT); }
                    dead = true; break; }
                __builtin_amdgcn_s_sleep(2);
            }
            __builtin_amdgcn_fence(__ATOMIC_ACQUIRE, "agent");
            if (lane == 0) flag[0] = dead ? 1u : 0u;
        }
        asm volatile("s_waitcnt vmcnt(0) lgkmcnt(0)" ::: "memory"); __builtin_amdgcn_s_barrier(); asm volatile("" ::: "memory");
        const bool bad = flag[0] != 0u;
        if (lane < 32) {
            const unsigned long long* slot = (const unsigned long long*)xbuf + (size_t)(u.pm * BM + row) * 4; float mt[4], m2[4]; float ms = 0.f;
#pragma unroll
            for (int t = 0; t < 4; ++t) { if (t < ntn) { const unsigned long long w = __hip_atomic_load(slot + t, __ATOMIC_RELAXED, __HIP_MEMORY_SCOPE_AGENT); mt[t] = __uint_as_float((unsigned)w); m2[t] = __uint_as_float((unsigned)(w >> 32)); } else { mt[t] = 0.f; m2[t] = 0.f; } ms += mt[t]; }
            const float mean = ms / (float)ntn; float q = 0.f;
#pragma unroll
            for (int t = 0; t < 4; ++t) if (t < ntn) { const float dm = mt[t] - mean; q += m2[t] + 256.0f * dm * dm; }
            S[row] = (f32x2v){mean, 1.0f / sqrtf(q / (256.0f * (float)ntn) + eps)};
        }
        asm volatile("s_waitcnt lgkmcnt(0)" ::: "memory"); __builtin_amdgcn_s_barrier(); asm volatile("" ::: "memory");
        return bad;
    }
};
struct EpiLnRes {
    static constexpr bool PERM = false, AFTER_DRAIN = true;
    const float* base; float* out; int ldc; const float* bias; PanelStats st; unsigned poison;
    __device__ __forceinline__ void fused(f32x4 (&acc)[2][2][4][2], const Unit& u, int wr, int wc, int fr, int fq, PG8_LAS unsigned char* lds, int wid, int lane) const {
        typedef float f32x2v __attribute__((ext_vector_type(2)));
        const PG8_LAS f32x2v* S = (const PG8_LAS f32x2v*)(lds + 8192);
        const int col0 = u.pn * BM + wc * 32 + 4 * fq;
#pragma unroll
        for (int bj = 0; bj < 2; ++bj)
#pragma unroll
            for (int n = 0; n < 2; ++n) { const f32x4 bv = bias ? *(const f32x4*)(bias + col0 + bj * HALF + n * 16) : (f32x4){0.f, 0.f, 0.f, 0.f};
#pragma unroll
                for (int ai = 0; ai < 2; ++ai)
#pragma unroll
                    for (int m = 0; m < 4; ++m) acc[ai][bj][m][n] += bv; }
        f32x4 pre[4][2][2];
#pragma unroll
        for (int m = 0; m < 4; ++m) { const size_t off = (size_t)(u.pm * BM + wr * 64 + m * 16 + fr) * ldc + col0;
#pragma unroll
            for (int bj = 0; bj < 2; ++bj)
#pragma unroll
                for (int n = 0; n < 2; ++n) pre[m][bj][n] = *(const f32x4*)(base + off + bj * HALF + n * 16); }
        const bool bad = st.run(acc, u, wr, wc, fr, fq, lds, wid, lane) || poison != 0u;
        const float qnan = __builtin_nanf("");
#pragma unroll
        for (int ai = 0; ai < 2; ++ai)
#pragma unroll
            for (int m = 0; m < 4; ++m) { const int r = ai * HALF + wr * 64 + m * 16 + fr; const f32x2v sr = S[r]; const size_t off = (size_t)(u.pm * BM + r) * ldc + col0;
#pragma unroll
                for (int bj = 0; bj < 2; ++bj)
#pragma unroll
                    for (int n = 0; n < 2; ++n) { const f32x4 bs = ai == 0 ? pre[m][bj][n] : *(const f32x4*)(base + off + bj * HALF + n * 16); f32x4 o = bs + (acc[ai][bj][m][n] - sr.x) * sr.y;
                        if (bad) o = (f32x4){qnan, qnan, qnan, qnan}; *(f32x4*)(out + off + bj * HALF + n * 16) = o; }
                if (m & 1) asm volatile("" ::: "memory"); }
    }
};
struct EpiLnResLn {
    static constexpr bool PERM = false, AFTER_DRAIN = true;
    const float* base; float* out; bf16_t* xn; int ldc; const float* bias; PanelStats st1, st2; unsigned poison;
    __device__ __forceinline__ void fused(f32x4 (&acc)[2][2][4][2], const Unit& u, int wr, int wc, int fr, int fq, PG8_LAS unsigned char* lds, int wid, int lane) const {
        typedef float f32x2v __attribute__((ext_vector_type(2))); typedef unsigned u32x2v __attribute__((ext_vector_type(2)));
        const PG8_LAS f32x2v* S = (const PG8_LAS f32x2v*)(lds + 8192);
        const int col0 = u.pn * BM + wc * 32 + 4 * fq;
#pragma unroll
        for (int bj = 0; bj < 2; ++bj)
#pragma unroll
            for (int n = 0; n < 2; ++n) { const f32x4 bv = bias ? *(const f32x4*)(bias + col0 + bj * HALF + n * 16) : (f32x4){0.f, 0.f, 0.f, 0.f};
#pragma unroll
                for (int ai = 0; ai < 2; ++ai)
#pragma unroll
                    for (int m = 0; m < 4; ++m) acc[ai][bj][m][n] += bv; }
        bool bad = st1.run(acc, u, wr, wc, fr, fq, lds, wid, lane) || poison != 0u;
        const float qnan = __builtin_nanf("");
#pragma unroll
        for (int ai = 0; ai < 2; ++ai)
#pragma unroll
            for (int m = 0; m < 4; ++m) { const int r = ai * HALF + wr * 64 + m * 16 + fr; const f32x2v sr = S[r]; const size_t off = (size_t)(u.pm * BM + r) * ldc + col0;
#pragma unroll
                for (int bj = 0; bj < 2; ++bj)
#pragma unroll
                    for (int n = 0; n < 2; ++n) { const f32x4 bs = *(const f32x4*)(base + off + bj * HALF + n * 16); acc[ai][bj][m][n] = bs + (acc[ai][bj][m][n] - sr.x) * sr.y; }
                asm volatile("" : "+v"(acc[ai][0][m][0]), "+v"(acc[ai][0][m][1]), "+v"(acc[ai][1][m][0]), "+v"(acc[ai][1][m][1]));
                if (m & 1) asm volatile("" ::: "memory"); }
        const bool bad1 = bad;
        bad = st2.run(acc, u, wr, wc, fr, fq, lds, wid, lane) || bad;
#pragma unroll
        for (int ai = 0; ai < 2; ++ai)
#pragma unroll
            for (int m = 0; m < 4; ++m) { const int r = ai * HALF + wr * 64 + m * 16 + fr; const f32x2v sr = S[r]; const size_t off = (size_t)(u.pm * BM + r) * ldc + col0;
#pragma unroll
                for (int bj = 0; bj < 2; ++bj)
#pragma unroll
                    for (int n = 0; n < 2; ++n) { const f32x4 x1 = acc[ai][bj][m][n]; *(f32x4*)(out + off + bj * HALF + n * 16) = bad1 ? (f32x4){qnan, qnan, qnan, qnan} : x1;
                        const f32x4 o = (x1 - sr.x) * sr.y; u32x2v w; w.x = cvt_pk_bf16(o[0], o[1]); w.y = cvt_pk_bf16(o[2], o[3]);
                        if (bad) { w.x = 0x7fc07fc0u; w.y = 0x7fc07fc0u; } *(u32x2v*)(xn + off + bj * HALF + n * 16) = w; }
                asm volatile("" ::: "memory"); }
    }
};

template <class Epi, class Sched, bool ALIGN_EPI = false, bool SP2 = false>
__device__ __forceinline__ void gemm_phase(PG8_LAS unsigned char* lds, const Gemm g, const Sched& S, const Epi& E) {
    int tid_ = threadIdx.x; asm volatile("" : "+v"(tid_));
    const int tid = tid_, wid = __builtin_amdgcn_readfirstlane(tid >> 6), lane = tid & 63, wr = wid >> 2, wc = wid & 3, fr = lane & 15, fq = lane >> 4;
    const int K = g.K, nt = K / BK;
    unsigned voffA[2], voffB[2];
#pragma unroll
    for (int i = 0; i < 2; ++i) { int R, C; stage_rc(tid * 16 + i * 8192, R, C); const int Rb = Epi::PERM ? ((R & ~31) + perm32(R & 31)) : R;
        voffA[i] = (unsigned)(R * K + C) * 2u; voffB[i] = (unsigned)(Rb * K + C) * 2u; }
    const size_t kstep = (size_t)(BK * 2);
    const size_t hstep = (size_t)HALF * K * 2;
    const size_t tstep = 2 * hstep;
    const unsigned ldsw = (unsigned)wid * 1024u;
    const int aoff = lds_byte(wr * 64 + fr, fq * 8), boff = lds_byte(wc * 32 + fr, fq * 8);
#define PG8_SA(b, h) (((b) * 2 + (h)) * HTB)
#define PG8_SB(b, h) ((4 + (b) * 2 + (h)) * HTB)
#define PG8_STAGE(bufoff, gbase, voff) do { _Pragma("unroll") for (int _i = 0; _i < 2; ++_i) \
        __builtin_amdgcn_global_load_lds((const unsigned*)((const char*)(gbase) + (voff)[_i]), (PG8_LAS unsigned*)(lds + (bufoff) + ldsw + _i * 8192), 16, 0, 0); } while (0)
#define PG8_LDA(dst, b, h) do { _Pragma("unroll") for (int m = 0; m < 4; ++m) _Pragma("unroll") for (int k = 0; k < 2; ++k) dst[m][k] = *(const PG8_LAS bf16x8*)(lds + PG8_SA(b, h) + aoff + m * 2048 + k * 1024); } while (0)
#define PG8_LDB(dst, b, h) do { _Pragma("unroll") for (int n = 0; n < 2; ++n) _Pragma("unroll") for (int k = 0; k < 2; ++k) dst[n][k] = *(const PG8_LAS bf16x8*)(lds + PG8_SB(b, h) + boff + n * 2048 + k * 1024); } while (0)
#define PG8_MMA(ai, bj, At, Bt) do { __builtin_amdgcn_s_setprio(1); _Pragma("unroll") for (int m = 0; m < 4; ++m) _Pragma("unroll") for (int n = 0; n < 2; ++n) _Pragma("unroll") for (int k = 0; k < 2; ++k) \
        acc[ai][bj][m][n] = __builtin_amdgcn_mfma_f32_16x16x32_bf16(Bt[n][k], At[m][k], acc[ai][bj][m][n], 0, 0, 0); __builtin_amdgcn_s_setprio(0); } while (0)
#define PG8_WAIT_V(n) asm volatile("s_waitcnt vmcnt(" #n ")" ::: "memory")
#define PG8_WAIT_L(n) asm volatile("s_waitcnt lgkmcnt(" #n ")" ::: "memory")
#define PG8_BAR __builtin_amdgcn_s_barrier()
#define PG8_SCHED __builtin_amdgcn_sched_barrier(0)
    Unit cur, nxt; int ui = 0;
    if (!S.next(0, cur)) return;
    f32x4 acc[2][2][4][2];
#pragma unroll
    for (int a = 0; a < 2; ++a)
#pragma unroll
        for (int b = 0; b < 2; ++b)
#pragma unroll
            for (int m = 0; m < 4; ++m)
#pragma unroll
                for (int n = 0; n < 2; ++n) acc[a][b][m][n] = (f32x4){0.f, 0.f, 0.f, 0.f};
    bf16x8 At[4][2], B0[2][2], B1[2][2];
    const char* cA = (const char*)g.A + (size_t)cur.pm * tstep; const char* cB = (const char*)g.Bt + (size_t)cur.pn * tstep;
    S.a_ready(cur);
    if constexpr (SP2) {
        PG8_STAGE(PG8_SB(0, 0), cB, voffB); PG8_STAGE(PG8_SB(0, 1), cB + hstep, voffB); PG8_STAGE(PG8_SA(0, 0), cA, voffA); PG8_STAGE(PG8_SA(0, 1), cA + hstep, voffA);
        if (wr == 1) PG8_BAR;
        PG8_WAIT_V(2); PG8_BAR;
        PG8_STAGE(PG8_SB(1, 0), cB + kstep, voffB); PG8_STAGE(PG8_SA(1, 0), cA + kstep, voffA); PG8_STAGE(PG8_SB(1, 1), cB + hstep + kstep, voffB);
        PG8_WAIT_V(6); PG8_BAR;
    } else {
        PG8_STAGE(PG8_SB(0, 0), cB, voffB); PG8_STAGE(PG8_SA(0, 0), cA, voffA); PG8_STAGE(PG8_SB(0, 1), cB + hstep, voffB); PG8_STAGE(PG8_SA(0, 1), cA + hstep, voffA);
        if (wr == 1) PG8_BAR;
        PG8_WAIT_V(4); PG8_BAR;
        PG8_STAGE(PG8_SB(1, 0), cB + kstep, voffB); PG8_STAGE(PG8_SA(1, 0), cA + kstep, voffA); PG8_STAGE(PG8_SB(1, 1), cB + hstep + kstep, voffB);
        PG8_WAIT_V(6); PG8_BAR;
    }
    for (;;) {
        const bool has_next = S.next(ui + 1, nxt);
        const char* nA = has_next ? (const char*)g.A + (size_t)nxt.pm * tstep : cA; const char* nB = has_next ? (const char*)g.Bt + (size_t)nxt.pn * tstep : cB;
        for (int t = 0; t < nt; t += 2) {
            const bool last = (t == nt - 2);
            const char* a1 = cA + (size_t)(t + 1) * kstep;
            const char* a2 = last ? nA : cA + (size_t)(t + 2) * kstep; const char* b2 = last ? nB : cB + (size_t)(t + 2) * kstep;
            const char* a3 = a2 + kstep; const char* b3 = b2 + kstep;
            if (last && has_next) S.a_ready(nxt);
            if constexpr (SP2) {
            PG8_LDB(B0, 0, 0); PG8_LDB(B1, 0, 1); PG8_SCHED; PG8_LDA(At, 0, 0); PG8_STAGE(PG8_SA(1, 1), a1 + hstep, voffA);
            PG8_WAIT_V(8); PG8_WAIT_L(0); PG8_BAR; PG8_MMA(0, 0, At, B0); PG8_MMA(0, 1, At, B1); PG8_BAR; PG8_SCHED;
            PG8_LDA(At, 0, 1); PG8_STAGE(PG8_SB(0, 0), b2, voffB); PG8_STAGE(PG8_SB(0, 1), b2 + hstep, voffB); PG8_STAGE(PG8_SA(0, 0), a2, voffA);
            PG8_WAIT_V(8); PG8_WAIT_L(0); PG8_BAR; PG8_MMA(1, 0, At, B0); PG8_MMA(1, 1, At, B1); PG8_BAR; PG8_SCHED;
            PG8_LDB(B0, 1, 0); PG8_LDB(B1, 1, 1); PG8_SCHED; PG8_LDA(At, 1, 0); PG8_STAGE(PG8_SA(0, 1), a2 + hstep, voffA);
            PG8_WAIT_V(8); PG8_WAIT_L(0); PG8_BAR; PG8_MMA(0, 0, At, B0); PG8_MMA(0, 1, At, B1); PG8_BAR; PG8_SCHED;
            PG8_LDA(At, 1, 1); PG8_STAGE(PG8_SB(1, 0), b3, voffB); PG8_STAGE(PG8_SB(1, 1), b3 + hstep, voffB); PG8_STAGE(PG8_SA(1, 0), a3, voffA);
            PG8_WAIT_V(8); PG8_WAIT_L(0); PG8_BAR; PG8_MMA(1, 0, At, B0); PG8_MMA(1, 1, At, B1); PG8_BAR; PG8_SCHED;
            } else {
            PG8_LDB(B0, 0, 0); PG8_SCHED; PG8_LDA(At, 0, 0); PG8_STAGE(PG8_SA(1, 1), a1 + hstep, voffA);
            PG8_WAIT_L(8); PG8_BAR; PG8_WAIT_L(0); PG8_MMA(0, 0, At, B0); PG8_BAR; PG8_SCHED;
            PG8_LDB(B1, 0, 1); PG8_STAGE(PG8_SB(0, 0), b2, voffB);
            PG8_BAR; PG8_WAIT_L(0); PG8_MMA(0, 1, At, B1); PG8_BAR;
            PG8_LDA(At, 0, 1); PG8_STAGE(PG8_SA(0, 0), a2, voffA);
            PG8_BAR; PG8_WAIT_L(0); PG8_MMA(1, 0, At, B0); PG8_BAR; PG8_SCHED;
            PG8_STAGE(PG8_SB(0, 1), b2 + hstep, voffB);
            PG8_WAIT_V(6); PG8_BAR; PG8_MMA(1, 1, At, B1); PG8_BAR;
            PG8_LDB(B0, 1, 0); PG8_SCHED; PG8_LDA(At, 1, 0); PG8_STAGE(PG8_SA(0, 1), a2 + hstep, voffA);
            PG8_WAIT_L(8); PG8_BAR; PG8_WAIT_L(0); PG8_MMA(0, 0, At, B0); PG8_BAR; PG8_SCHED;
            PG8_LDB(B1, 1, 1); PG8_STAGE(PG8_SB(1, 0), b3, voffB);
            PG8_BAR; PG8_WAIT_L(0); PG8_MMA(0, 1, At, B1); PG8_BAR;
            PG8_LDA(At, 1, 1); PG8_STAGE(PG8_SA(1, 0), a3, voffA);
            PG8_BAR; PG8_WAIT_L(0); PG8_MMA(1, 0, At, B0); PG8_BAR; PG8_SCHED;
            PG8_STAGE(PG8_SB(1, 1), b3 + hstep, voffB);
            PG8_WAIT_V(6); PG8_BAR; PG8_MMA(1, 1, At, B1); PG8_BAR;
            }
        }
        if constexpr (ALIGN_EPI) { if (wr == 0) PG8_BAR; }
        if constexpr (!Epi::AFTER_DRAIN) { E(acc, cur, wr, wc, fr, fq); S.done(cur); }
        if (!has_next) break;
#pragma unroll
        for (int a = 0; a < 2; ++a)
#pragma unroll
            for (int b = 0; b < 2; ++b)
#pragma unroll
                for (int m = 0; m < 4; ++m)
#pragma unroll
                    for (int n = 0; n < 2; ++n) acc[a][b][m][n] = (f32x4){0.f, 0.f, 0.f, 0.f};
        cur = nxt; cA = nA; cB = nB; ++ui;
        if constexpr (ALIGN_EPI) { if (wr == 1) PG8_BAR; }
    }
    PG8_WAIT_V(0);
    if constexpr (!ALIGN_EPI) { if (wr == 0) PG8_BAR; }
    PG8_BAR;
    if constexpr (Epi::AFTER_DRAIN) { E.fused(acc, cur, wr, wc, fr, fq, lds, wid, lane); S.done(cur); }
#undef PG8_SA
#undef PG8_SB
#undef PG8_STAGE
#undef PG8_LDA
#undef PG8_LDB
#undef PG8_MMA
#undef PG8_WAIT_V
#undef PG8_WAIT_L
#undef PG8_BAR
#undef PG8_SCHED
}
}

#ifndef PG8_SP2
#define PG8_SP2 true
#endif
#ifndef PG8_ALIGN
#define PG8_ALIGN true
#endif
#include <hip/hip_cooperative_groups.h>
namespace cg = cooperative_groups;

constexpr int BATCH = 8, SEQ = 2048, D = 1024, M = BATCH * SEQ, FF = 2816, PLE = 256, DEPTH = 2;
constexpr float EPS = 1e-6f;
constexpr float LOG2E = 1.4426950408889634f;
constexpr int NWAVES = 8;
constexpr int LDS_BYTES = 147456;
#define LAS __attribute__((address_space(3)))
typedef unsigned short bf16_t;
typedef float f32x4 __attribute__((ext_vector_type(4)));
typedef unsigned u32x4 __attribute__((ext_vector_type(4)));
typedef unsigned u32x2 __attribute__((ext_vector_type(2)));
typedef short bf16x8 __attribute__((ext_vector_type(8)));
typedef float f32x16 __attribute__((ext_vector_type(16)));

constexpr size_t MiB = 1u << 20;
constexpr size_t WS_CTL = 0;
constexpr size_t WS_W1IN = 1 * MiB;
constexpr size_t WS_W1OUT = WS_W1IN + (size_t)2 * FF * D * 2;
constexpr size_t WS_W2IN = WS_W1OUT + (size_t)D * FF * 2;
constexpr size_t WS_W2OUT = WS_W2IN + (size_t)2 * FF * D * 2;
constexpr size_t WS_WQKV = WS_W2OUT + (size_t)D * FF * 2;
constexpr size_t WS_WO = WS_WQKV + (size_t)3 * D * D * 2;
constexpr size_t WS_WPROJ = WS_WO + (size_t)D * D * 2;
constexpr size_t WS_WGATE = WS_WPROJ + (size_t)D * PLE * 2;
constexpr size_t WS_WEND = WS_WGATE + (size_t)D * D * 2;
static_assert(WS_WEND <= 48 * MiB, "weights");
constexpr size_t WS_Y = 48 * MiB;
constexpr size_t WS_QK = 112 * MiB;
constexpr size_t WS_VT = 176 * MiB;
constexpr size_t WS_H = 112 * MiB;
constexpr size_t WS_E = 112 * MiB;
constexpr size_t WS_XN = 208 * MiB;
constexpr size_t WS_PB = 240 * MiB;
constexpr size_t WS_END = 248 * MiB;

__device__ __forceinline__ unsigned pk2bf(float lo, float hi) {
    typedef float f2 __attribute__((ext_vector_type(2))); typedef __bf16 b2 __attribute__((ext_vector_type(2)));
    f2 v = {lo, hi}; b2 b = __builtin_convertvector(v, b2); return __builtin_bit_cast(unsigned, b);
}
__device__ __forceinline__ float bf2f(unsigned short h) { return __builtin_bit_cast(float, (unsigned)h << 16); }
__device__ __forceinline__ float wave_sum(float v) {
#pragma unroll
    for (int o = 1; o < 64; o <<= 1) v += __shfl_xor(v, o);
    return v;
}
__device__ __forceinline__ float fast_sigmoid(float x) { return __builtin_amdgcn_rcpf(1.0f + __builtin_amdgcn_exp2f(-x * LOG2E)); }

struct EpiF32 {
    static constexpr bool PERM = false, AFTER_DRAIN = false;
    float* out; int ldc;
    __device__ __forceinline__ void operator()(const pg8::f32x4 (&acc)[2][2][4][2], const pg8::Unit& u, int wr, int wc, int fr, int fq) const {
        const int col0 = u.pn * 256 + wc * 32 + 4 * fq;
#pragma unroll
        for (int ai = 0; ai < 2; ++ai)
#pragma unroll
            for (int m = 0; m < 4; ++m) { float* rowp = out + (size_t)(u.pm * 256 + ai * 128 + wr * 64 + m * 16 + fr) * ldc + col0;
#pragma unroll
                for (int bj = 0; bj < 2; ++bj)
#pragma unroll
                    for (int n = 0; n < 2; ++n) *(pg8::f32x4*)(rowp + bj * 128 + n * 16) = acc[ai][bj][m][n]; }
    }
};
struct EpiBf {
    static constexpr bool PERM = true, AFTER_DRAIN = false;
    bf16_t* out; int ldc;
    __device__ __forceinline__ void operator()(const pg8::f32x4 (&acc)[2][2][4][2], const pg8::Unit& u, int wr, int wc, int fr, int fq) const {
        const int col0 = u.pn * 256 + wc * 32 + 8 * fq;
#pragma unroll
        for (int ai = 0; ai < 2; ++ai)
#pragma unroll
            for (int m = 0; m < 4; ++m) { bf16_t* rowp = out + (size_t)(u.pm * 256 + ai * 128 + wr * 64 + m * 16 + fr) * ldc + col0;
#pragma unroll
                for (int bj = 0; bj < 2; ++bj) { const pg8::f32x4 v0 = acc[ai][bj][m][0], v1 = acc[ai][bj][m][1]; u32x4 w;
                    w.x = pk2bf(v0[0], v0[1]); w.y = pk2bf(v0[2], v0[3]); w.z = pk2bf(v1[0], v1[1]); w.w = pk2bf(v1[2], v1[3]);
                    *(u32x4*)(rowp + bj * 128) = w; } }
    }
};
struct EpiSwiglu {
    static constexpr bool PERM = true, AFTER_DRAIN = false;
    bf16_t* out;
    __device__ __forceinline__ void operator()(const pg8::f32x4 (&acc)[2][2][4][2], const pg8::Unit& u, int wr, int wc, int fr, int fq) const {
        const int col0 = u.pn * 128 + wc * 32 + 8 * fq;
#pragma unroll
        for (int ai = 0; ai < 2; ++ai)
#pragma unroll
            for (int m = 0; m < 4; ++m) { bf16_t* rowp = out + (size_t)(u.pm * 256 + ai * 128 + wr * 64 + m * 16 + fr) * FF + col0;
                float h[8];
#pragma unroll
                for (int n = 0; n < 2; ++n)
#pragma unroll
                    for (int j = 0; j < 4; ++j) { const float a = acc[ai][0][m][n][j], b = acc[ai][1][m][n][j]; h[n * 4 + j] = a * fast_sigmoid(a) * b; }
                u32x4 w; w.x = pk2bf(h[0], h[1]); w.y = pk2bf(h[2], h[3]); w.z = pk2bf(h[4], h[5]); w.w = pk2bf(h[6], h[7]);
                *(u32x4*)rowp = w; }
    }
};
struct EpiGate {
    static constexpr bool PERM = false, AFTER_DRAIN = false;
    float* out; const bf16_t* E;
    __device__ __forceinline__ void operator()(const pg8::f32x4 (&acc)[2][2][4][2], const pg8::Unit& u, int wr, int wc, int fr, int fq) const {
        const int col0 = u.pn * 256 + wc * 32 + 4 * fq;
#pragma unroll
        for (int ai = 0; ai < 2; ++ai)
#pragma unroll
            for (int m = 0; m < 4; ++m) { const size_t off = (size_t)(u.pm * 256 + ai * 128 + wr * 64 + m * 16 + fr) * D + col0;
#pragma unroll
                for (int bj = 0; bj < 2; ++bj)
#pragma unroll
                    for (int n = 0; n < 2; ++n) { const u32x2 ev = *(const u32x2*)(E + off + bj * 128 + n * 16); const pg8::f32x4 a = acc[ai][bj][m][n]; pg8::f32x4 o;
                        o[0] = fast_sigmoid(a[0]) * __builtin_bit_cast(float, ev.x << 16); o[1] = fast_sigmoid(a[1]) * __builtin_bit_cast(float, ev.x & 0xffff0000u);
                        o[2] = fast_sigmoid(a[2]) * __builtin_bit_cast(float, ev.y << 16); o[3] = fast_sigmoid(a[3]) * __builtin_bit_cast(float, ev.y & 0xffff0000u);
                        *(pg8::f32x4*)(out + off + bj * 128 + n * 16) = o; } }
    }
};

template <int MODE>
__device__ __forceinline__ void transpose_item(const float* W, int K, int N, bf16_t* WT, LAS float* scr, int item, int lane) {
    const int nblk = N / 32, kb = item / nblk, nb = item % nblk, k0 = 64 * kb, n0 = 32 * nb;
#pragma unroll 8
    for (int i = 0; i < 32; ++i) { const int kk = 2 * i + (lane >> 5); scr[kk * 33 + (lane & 31)] = W[(size_t)(k0 + kk) * N + n0 + (lane & 31)]; }
    asm volatile("s_waitcnt lgkmcnt(0)" ::: "memory");
    int r0 = n0;
    if (MODE == 1) { const int half = n0 >= FF ? 1 : 0; const int j = n0 - half * FF; r0 = (j >> 7) * 256 + half * 128 + (j & 127); }
    const int c = lane & 7;
#pragma unroll
    for (int j = 0; j < 4; ++j) { const int n = (lane >> 3) + 8 * j; const LAS float* s = scr + (8 * c) * 33 + n;
        u32x4 o; o.x = pk2bf(s[0 * 33], s[1 * 33]); o.y = pk2bf(s[2 * 33], s[3 * 33]); o.z = pk2bf(s[4 * 33], s[5 * 33]); o.w = pk2bf(s[6 * 33], s[7 * 33]);
        *(u32x4*)(WT + (size_t)(r0 + n) * K + k0 + 8 * c) = o; }
    asm volatile("s_waitcnt lgkmcnt(0)" ::: "memory");
}

struct LayerW { const float *w1in, *w1out, *w2in, *w2out, *wqkv, *wo, *wproj, *wgate; };
__device__ __forceinline__ void convert_weights(const LayerW& L, unsigned char* ws, LAS float* scr, int gw, int NGW, int lane) {
    constexpr int I_IN = (D / 64) * (2 * FF / 32), I_OUT = (FF / 64) * (D / 32), I_QKV = (D / 64) * (3 * D / 32), I_O = (D / 64) * (D / 32), I_P = (PLE / 64) * (D / 32);
    constexpr int NITEMS = 2 * I_IN + 2 * I_OUT + I_QKV + 2 * I_O + I_P;
    for (int it = gw; it < NITEMS; it += NGW) {
        int r = it;
        if (r < I_IN) { transpose_item<1>(L.w1in, D, 2 * FF, (bf16_t*)(ws + WS_W1IN), scr, r, lane); continue; } r -= I_IN;
        if (r < I_IN) { transpose_item<1>(L.w2in, D, 2 * FF, (bf16_t*)(ws + WS_W2IN), scr, r, lane); continue; } r -= I_IN;
        if (r < I_OUT) { transpose_item<0>(L.w1out, FF, D, (bf16_t*)(ws + WS_W1OUT), scr, r, lane); continue; } r -= I_OUT;
        if (r < I_OUT) { transpose_item<0>(L.w2out, FF, D, (bf16_t*)(ws + WS_W2OUT), scr, r, lane); continue; } r -= I_OUT;
        if (r < I_QKV) { transpose_item<0>(L.wqkv, D, 3 * D, (bf16_t*)(ws + WS_WQKV), scr, r, lane); continue; } r -= I_QKV;
        if (r < I_O) { transpose_item<0>(L.wo, D, D, (bf16_t*)(ws + WS_WO), scr, r, lane); continue; } r -= I_O;
        if (r < I_O) { transpose_item<0>(L.wgate, D, D, (bf16_t*)(ws + WS_WGATE), scr, r, lane); continue; } r -= I_O;
        transpose_item<0>(L.wproj, PLE, D, (bf16_t*)(ws + WS_WPROJ), scr, r, lane);
    }
}

__device__ __forceinline__ void rows_phase(const float* Y, float coef, const float* gpost, const float* gpre, const float* xin, float* xout, bf16_t* XN, int gw, int NGW, int lane) {
    for (int m = gw; m < M; m += NGW) {
        const f32x4* xr = (const f32x4*)(xin + (size_t)m * D) + lane;
        f32x4 xv[4];
#pragma unroll
        for (int j = 0; j < 4; ++j) xv[j] = xr[64 * j];
        if (Y) {
            const f32x4* yr = (const f32x4*)(Y + (size_t)m * D) + lane; f32x4 yv[4]; float ss = 0.f;
#pragma unroll
            for (int j = 0; j < 4; ++j) { yv[j] = yr[64 * j]; ss += (yv[j].x * yv[j].x + yv[j].y * yv[j].y) + (yv[j].z * yv[j].z + yv[j].w * yv[j].w); }
            const float r = coef * __builtin_amdgcn_rsqf(wave_sum(ss) * (1.f / D) + EPS);
#pragma unroll
            for (int j = 0; j < 4; ++j) { const f32x4 g = ((const f32x4*)gpost)[lane + 64 * j]; xv[j] = xv[j] + yv[j] * g * r; }
        }
        if (Y || xin != xout) { f32x4* xo = (f32x4*)(xout + (size_t)m * D) + lane;
#pragma unroll
            for (int j = 0; j < 4; ++j) xo[64 * j] = xv[j]; }
        if (gpre) {
            float ss = 0.f;
#pragma unroll
            for (int j = 0; j < 4; ++j) ss += (xv[j].x * xv[j].x + xv[j].y * xv[j].y) + (xv[j].z * xv[j].z + xv[j].w * xv[j].w);
            const float r = __builtin_amdgcn_rsqf(wave_sum(ss) * (1.f / D) + EPS);
            u32x2* o8 = (u32x2*)(XN + (size_t)m * D) + lane;
#pragma unroll
            for (int j = 0; j < 4; ++j) { const f32x4 g = ((const f32x4*)gpre)[lane + 64 * j]; const f32x4 v = xv[j] * g * r; u32x2 w; w.x = pk2bf(v.x, v.y); w.y = pk2bf(v.z, v.w); o8[64 * j] = w; }
        }
    }
}
__device__ __forceinline__ void p_to_bf16(const float* P, bf16_t* PB, int gw, int NGW, int lane) {
    for (int m = gw; m < M; m += NGW) { const f32x4 v = ((const f32x4*)(P + (size_t)m * PLE))[lane]; u32x2 w; w.x = pk2bf(v.x, v.y); w.y = pk2bf(v.z, v.w); ((u32x2*)(PB + (size_t)m * PLE))[lane] = w; }
}

__device__ __forceinline__ int crow(int r, int hb) { return (r & 3) + 8 * (r >> 2) + 4 * hb; }
__device__ __forceinline__ int swap23(int i) { return (i & ~12) | ((i & 4) << 1) | ((i & 8) >> 1); }
#define MFMA32(a, b, c) __builtin_amdgcn_mfma_f32_32x32x16_bf16((a), (b), (c), 0, 0, 0)

__device__ __forceinline__ void da_unit(const bf16_t* QK, const bf16_t* VT, bf16_t* O, int b, int h, int qb, int c, float lam, float slope2,
                                        const float* subln_g, float outscale, LAS float* xch, LAS unsigned char* stg, int lane) {
    const int r32 = lane & 31, hb = lane >> 5;
    const size_t tok0 = (size_t)b * SEQ;
    const bf16_t* qp = QK + (tok0 + 32 * qb + r32) * 2048 + h * 128 + c * 64 + 8 * hb;
    bf16x8 qf[4];
#pragma unroll
    for (int d0 = 0; d0 < 4; ++d0) qf[d0] = *(const bf16x8*)(qp + 16 * d0);
    f32x16 o[4];
#pragma unroll
    for (int eb = 0; eb < 4; ++eb)
#pragma unroll
        for (int r = 0; r < 16; ++r) o[eb][r] = 0.f;
    float mref = -INFINITY, l = 0.f;
    const int nkb = 2 * ((qb >> 1) + 1);
    const int tq = 32 * qb + r32;
    const bf16_t* kbase = QK + (tok0 + swap23(r32)) * 2048 + 1024 + h * 128 + c * 64 + 8 * hb;
    const bf16_t* vbase = VT + (size_t)(h * 128 + r32) * M + tok0 + 8 * hb;
    constexpr float SC2 = 0.125f * LOG2E;
    for (int kb = nkb - 1; kb >= 0; --kb) {
        const bf16_t* kp = kbase + (size_t)(32 * kb) * 2048;
        bf16x8 kf[4];
#pragma unroll
        for (int d0 = 0; d0 < 4; ++d0) kf[d0] = *(const bf16x8*)(kp + 16 * d0);
        bf16x8 vf[4][2];
#pragma unroll
        for (int eb = 0; eb < 4; ++eb)
#pragma unroll
            for (int ks = 0; ks < 2; ++ks) vf[eb][ks] = *(const bf16x8*)(vbase + (size_t)(32 * eb) * M + 32 * kb + 16 * ks);
        f32x16 s;
#pragma unroll
        for (int r = 0; r < 16; ++r) s[r] = 0.f;
#pragma unroll
        for (int d0 = 0; d0 < 4; ++d0) s = MFMA32(kf[d0], qf[d0], s);
        const int dq = tq - (32 * kb + 8 * hb);
        float bm = -INFINITY;
#pragma unroll
        for (int r = 0; r < 16; ++r) { const int dd = dq - (16 * (r >> 3) + (r & 7)); const float dist = (float)(dd < 0 ? -dd : dd); s[r] = s[r] * SC2 - slope2 * dist; bm = fmaxf(bm, s[r]); }
        bm = fmaxf(bm, __shfl_xor(bm, 32));
        if (__any(bm > mref + 8.0f)) {
            const float mn = fmaxf(mref, bm); const float al = __builtin_amdgcn_exp2f(mref - mn); l *= al;
#pragma unroll
            for (int eb = 0; eb < 4; ++eb)
#pragma unroll
                for (int r = 0; r < 16; ++r) o[eb][r] *= al;
            mref = mn;
        }
        float ps = 0.f;
#pragma unroll
        for (int r = 0; r < 16; ++r) { s[r] = __builtin_amdgcn_exp2f(s[r] - mref); ps += s[r]; }
        l += ps;
        bf16x8 pb[2];
#pragma unroll
        for (int ks = 0; ks < 2; ++ks) { u32x4 w; w.x = pk2bf(s[8 * ks + 0], s[8 * ks + 1]); w.y = pk2bf(s[8 * ks + 2], s[8 * ks + 3]); w.z = pk2bf(s[8 * ks + 4], s[8 * ks + 5]); w.w = pk2bf(s[8 * ks + 6], s[8 * ks + 7]); pb[ks] = __builtin_bit_cast(bf16x8, w); }
#pragma unroll
        for (int eb = 0; eb < 4; ++eb)
#pragma unroll
            for (int ks = 0; ks < 2; ++ks) o[eb] = MFMA32(vf[eb][ks], pb[ks], o[eb]);
    }
    l += __shfl_xor(l, 32);
    const float inv = 1.0f / l;
    if (c == 1) { const float w = -lam * inv;
#pragma unroll
        for (int eb = 0; eb < 4; ++eb)
#pragma unroll
            for (int r = 0; r < 16; ++r) xch[(eb * 16 + r) * 64 + lane] = o[eb][r] * w; }
    __syncthreads();
    if (c == 0) {
        float ss = 0.f;
#pragma unroll
        for (int eb = 0; eb < 4; ++eb)
#pragma unroll
            for (int r = 0; r < 16; ++r) { const float v = o[eb][r] * inv + xch[(eb * 16 + r) * 64 + lane]; o[eb][r] = v; ss += v * v; }
        ss += __shfl_xor(ss, 32);
        const float rn = __builtin_amdgcn_rsqf(ss * (1.f / 128.f) + EPS) * outscale;
#pragma unroll
        for (int eb = 0; eb < 4; ++eb)
#pragma unroll
            for (int r = 0; r < 16; r += 2) { const int e = 32 * eb + crow(r, hb); const float v0 = o[eb][r] * rn * subln_g[e], v1 = o[eb][r + 1] * rn * subln_g[e + 1];
                *(LAS unsigned*)(stg + r32 * 272 + e * 2) = pk2bf(v0, v1); }
        asm volatile("s_waitcnt lgkmcnt(0)" ::: "memory");
#pragma unroll
        for (int i = 0; i < 8; ++i) { const int idx = i * 64 + lane, row = idx >> 4, ch = idx & 15; const u32x4 v = *(const LAS u32x4*)(stg + row * 272 + ch * 16);
            *(u32x4*)(O + (tok0 + 32 * qb + row) * D + h * 128 + ch * 8) = v; }
    }
    __syncthreads();
}

__device__ __forceinline__ void sb_unit(const bf16_t* QK, const bf16_t* VT, bf16_t* O, int b, int h, int qb, LAS unsigned char* stg, int lane) {
    const int r32 = lane & 31, hb = lane >> 5;
    const size_t tok0 = (size_t)b * SEQ;
    const bf16_t* qp = QK + (tok0 + 32 * qb + r32) * 2048 + h * 64 + 8 * hb;
    bf16x8 qf[4];
#pragma unroll
    for (int d0 = 0; d0 < 4; ++d0) qf[d0] = *(const bf16x8*)(qp + 16 * d0);
    f32x16 o[2];
#pragma unroll
    for (int eb = 0; eb < 2; ++eb)
#pragma unroll
        for (int r = 0; r < 16; ++r) o[eb][r] = 0.f;
    float carry = 1.0f;
    const bf16_t* kbase = QK + (tok0 + swap23(r32)) * 2048 + 1024 + h * 64 + 8 * hb;
    const bf16_t* vbase = VT + (size_t)(h * 64 + r32) * M + tok0 + 8 * hb;
    constexpr float SC2 = 0.125f * LOG2E;
    for (int kb = qb; kb >= 0; --kb) {
        const bf16_t* kp = kbase + (size_t)(32 * kb) * 2048;
        bf16x8 kf[4];
#pragma unroll
        for (int d0 = 0; d0 < 4; ++d0) kf[d0] = *(const bf16x8*)(kp + 16 * d0);
        bf16x8 vf[2][2];
#pragma unroll
        for (int eb = 0; eb < 2; ++eb)
#pragma unroll
            for (int ks = 0; ks < 2; ++ks) vf[eb][ks] = *(const bf16x8*)(vbase + (size_t)(32 * eb) * M + 32 * kb + 16 * ks);
        f32x16 s;
#pragma unroll
        for (int r = 0; r < 16; ++r) s[r] = 0.f;
#pragma unroll
        for (int d0 = 0; d0 < 4; ++d0) s = MFMA32(kf[d0], qf[d0], s);
        float om[16];
#pragma unroll
        for (int r = 0; r < 16; ++r) { const float e = __builtin_amdgcn_exp2f(s[r] * SC2); om[r] = __builtin_amdgcn_rcpf(1.0f + e); }
        if (kb == qb) {
            const int dq = r32 - 8 * hb;
#pragma unroll
            for (int r = 0; r < 16; ++r) { if (dq - (16 * (r >> 3) + (r & 7)) <= 0) om[r] = 1.0f; }
        }
        float sufA[8], sufB[8];
        sufA[7] = 1.0f; sufB[7] = 1.0f;
#pragma unroll
        for (int j = 6; j >= 0; --j) { sufA[j] = sufA[j + 1] * om[j + 1]; sufB[j] = sufB[j + 1] * om[8 + j + 1]; }
        const float TA = sufA[0] * om[0], TB = sufB[0] * om[8];
        const float pTA = __shfl_xor(TA, 32), pTB = __shfl_xor(TB, 32);
        const float multB = hb ? carry : carry * pTB;
        const float multA = hb ? carry * TB * pTB : carry * pTB * TB * pTA;
        carry = carry * ((TA * TB) * (pTA * pTB));
        float a[16];
#pragma unroll
        for (int j = 0; j < 8; ++j) { a[j] = (1.0f - om[j]) * sufA[j] * multA; a[8 + j] = (1.0f - om[8 + j]) * sufB[j] * multB; }
        bf16x8 pb[2];
#pragma unroll
        for (int ks = 0; ks < 2; ++ks) { u32x4 w; w.x = pk2bf(a[8 * ks + 0], a[8 * ks + 1]); w.y = pk2bf(a[8 * ks + 2], a[8 * ks + 3]); w.z = pk2bf(a[8 * ks + 4], a[8 * ks + 5]); w.w = pk2bf(a[8 * ks + 6], a[8 * ks + 7]); pb[ks] = __builtin_bit_cast(bf16x8, w); }
#pragma unroll
        for (int eb = 0; eb < 2; ++eb)
#pragma unroll
            for (int ks = 0; ks < 2; ++ks) o[eb] = MFMA32(vf[eb][ks], pb[ks], o[eb]);
    }
#pragma unroll
    for (int eb = 0; eb < 2; ++eb)
#pragma unroll
        for (int r = 0; r < 16; r += 2) { const int e = 32 * eb + crow(r, hb); *(LAS unsigned*)(stg + r32 * 144 + e * 2) = pk2bf(o[eb][r], o[eb][r + 1]); }
    asm volatile("s_waitcnt lgkmcnt(0)" ::: "memory");
#pragma unroll
    for (int i = 0; i < 4; ++i) { const int idx = i * 64 + lane, row = idx >> 3, ch = idx & 7; const u32x4 v = *(const LAS u32x4*)(stg + row * 144 + ch * 16);
        *(u32x4*)(O + (tok0 + 32 * qb + row) * D + h * 64 + ch * 8) = v; }
    asm volatile("s_waitcnt lgkmcnt(0)" ::: "memory");
}

struct Args { const float* in[15]; float* out; unsigned char* ws; };
static_assert(sizeof(Args) == 15 * 8 + 8 + 8, "Args has no padding");
struct KA {
    const unsigned char* p;
    __device__ __forceinline__ KA() { p = (const unsigned char*)__builtin_amdgcn_kernarg_segment_ptr(); asm volatile("" : "+s"(p)); }
    __device__ __forceinline__ const float* in(int i) const { return *(const float* const*)(p + 8 * i); }
    __device__ __forceinline__ float* out() const { return *(float* const*)(p + 120); }
    __device__ __forceinline__ unsigned char* ws() const { return *(unsigned char* const*)(p + 128); }
};
struct WaveId { int lane, wave, gw, NGW, G, bx; };
__device__ __forceinline__ WaveId wave_id() { int t = threadIdx.x; asm volatile("" : "+v"(t)); WaveId w; w.lane = t & 63; w.wave = __builtin_amdgcn_readfirstlane(t >> 6); w.G = gridDim.x; w.bx = blockIdx.x; w.gw = w.bx * NWAVES + w.wave; w.NGW = w.G * NWAVES; return w; }
__device__ __forceinline__ void layer_weights(const KA& ka, int i, LayerW& L) { L.w1in = ka.in(3) + (size_t)i * D * 2 * FF; L.w1out = ka.in(4) + (size_t)i * FF * D; L.w2in = ka.in(5) + (size_t)i * D * 2 * FF; L.w2out = ka.in(6) + (size_t)i * FF * D;
    L.wqkv = (i == 0) ? ka.in(7) : ka.in(11); L.wo = (i == 0) ? ka.in(8) : ka.in(12); L.wproj = ka.in(13) + (size_t)i * PLE * D; L.wgate = ka.in(14) + (size_t)i * D * D; }

#define SEAM() grid.sync()
#ifndef PMASK
#define PMASK 0xffff
#endif
#define EN(k) ((PMASK >> (k)) & 1)
template <class Epi> __device__ __forceinline__ void run_gemm(LAS unsigned char* lds, const bf16_t* A, const bf16_t* Bt, int Mr, int Nr, int Kr, const Epi& E) {
    pg8::Gemm gm{A, Bt, Mr, Nr, Kr}; pg8::StaticOrder S; S.init(Mr, Nr, (int)gridDim.x, (int)blockIdx.x);
    pg8::gemm_phase<Epi, pg8::StaticOrder, PG8_ALIGN, PG8_SP2>(lds, gm, S, E);
}

template <int LAYER> __device__ __forceinline__ void layer_body(LAS unsigned char* lds, cg::grid_group& grid) {
    if (EN(0)) { KA ka; unsigned char* ws = ka.ws(); EpiSwiglu E{(bf16_t*)(ws + WS_H)}; run_gemm(lds, (const bf16_t*)(ws + WS_XN), (const bf16_t*)(ws + WS_W1IN), M, 2 * FF, D, E); }
    SEAM();
    if (EN(1)) { KA ka; unsigned char* ws = ka.ws(); EpiF32 E{(float*)(ws + WS_Y), D}; run_gemm(lds, (const bf16_t*)(ws + WS_H), (const bf16_t*)(ws + WS_W1OUT), M, D, FF, E); }
    SEAM();
    if (EN(2)) { KA ka; unsigned char* ws = ka.ws(); const WaveId w = wave_id(); const float* g = ka.in(2) + (size_t)LAYER * 8 * D; float* xres = ka.out();
        rows_phase((const float*)(ws + WS_Y), 0.5f, g + 1 * D, g + 2 * D, xres, xres, (bf16_t*)(ws + WS_XN), w.gw, w.NGW, w.lane); }
    SEAM();
    if (EN(3)) {
        { KA ka; unsigned char* ws = ka.ws(); EpiBf E{(bf16_t*)(ws + WS_QK), 2 * D}; run_gemm(lds, (const bf16_t*)(ws + WS_XN), (const bf16_t*)(ws + WS_WQKV), M, 2 * D, D, E); }
        { KA ka; unsigned char* ws = ka.ws(); EpiBf E{(bf16_t*)(ws + WS_VT), M}; run_gemm(lds, (const bf16_t*)(ws + WS_WQKV) + (size_t)2 * D * D, (const bf16_t*)(ws + WS_XN), D, M, D, E); }
    }
    SEAM();
    if (EN(4)) {
        KA ka; unsigned char* ws = ka.ws(); const WaveId w = wave_id();
        const bf16_t* QK = (const bf16_t*)(ws + WS_QK); const bf16_t* VT = (const bf16_t*)(ws + WS_VT); bf16_t* O = (bf16_t*)(ws + WS_XN);
#ifndef NO_DA
        if (LAYER == 0) {
            const float* lv = ka.in(9); const float* subln = ka.in(10);
            const float lambda_init = 0.8f - 0.6f * 1.0f;
            const float s1 = wave_sum(lv[w.lane] * lv[64 + w.lane]), s2 = wave_sum(lv[128 + w.lane] * lv[192 + w.lane]);
            const float lam = __expf(s1) - __expf(s2) + lambda_init;
            const int wp = w.bx * 4 + (w.wave >> 1), c = w.wave & 1;
            const int bh = wp >> 4, j0 = (wp & 15) * 2;
            const int b = bh >> 3, h = bh & 7;
            const float slope2 = exp2f(-(float)(h + 1)) * LOG2E;
            LAS float* xch = (LAS float*)(lds + (w.wave >> 1) * 32768);
            LAS unsigned char* stg = lds + (w.wave >> 1) * 32768 + 16384;
#pragma unroll 1
            for (int u = 0; u < 4; ++u) { const int j = j0 + (u >> 1); const int qb = (u & 1) ? 63 - j : j;
                da_unit(QK, VT, O, b, h, qb, c, lam, slope2, subln, 1.0f - lambda_init, xch, stg, w.lane); }
        }
#endif
#ifndef NO_SB
        if (LAYER == 1) {
            const int bh = w.gw >> 4, j0 = (w.gw & 15) * 2;
            const int b = bh >> 4, h = bh & 15;
            LAS unsigned char* stg = lds + w.wave * 8192;
#pragma unroll 1
            for (int u = 0; u < 4; ++u) { const int j = j0 + (u >> 1); const int qb = (u & 1) ? 63 - j : j;
                sb_unit(QK, VT, O, b, h, qb, stg, w.lane); }
        }
#endif
    }
    SEAM();
    if (EN(5)) { KA ka; unsigned char* ws = ka.ws(); EpiF32 E{(float*)(ws + WS_Y), D}; run_gemm(lds, (const bf16_t*)(ws + WS_XN), (const bf16_t*)(ws + WS_WO), M, D, D, E); }
    SEAM();
    if (EN(6)) { KA ka; unsigned char* ws = ka.ws(); const WaveId w = wave_id(); const float* g = ka.in(2) + (size_t)LAYER * 8 * D; float* xres = ka.out();
        rows_phase((const float*)(ws + WS_Y), 1.0f, g + 3 * D, g + 4 * D, xres, xres, (bf16_t*)(ws + WS_XN), w.gw, w.NGW, w.lane);
        p_to_bf16(ka.in(1) + (size_t)LAYER * M * PLE, (bf16_t*)(ws + WS_PB), w.gw, w.NGW, w.lane); }
    SEAM();
    if (EN(7)) { KA ka; unsigned char* ws = ka.ws(); EpiSwiglu E{(bf16_t*)(ws + WS_H)}; run_gemm(lds, (const bf16_t*)(ws + WS_XN), (const bf16_t*)(ws + WS_W2IN), M, 2 * FF, D, E); }
    SEAM();
    if (EN(8)) { KA ka; unsigned char* ws = ka.ws(); EpiF32 E{(float*)(ws + WS_Y), D}; run_gemm(lds, (const bf16_t*)(ws + WS_H), (const bf16_t*)(ws + WS_W2OUT), M, D, FF, E); }
    SEAM();
    if (EN(9)) {
        { KA ka; unsigned char* ws = ka.ws(); const WaveId w = wave_id(); const float* g = ka.in(2) + (size_t)LAYER * 8 * D; float* xres = ka.out();
          rows_phase((const float*)(ws + WS_Y), 0.5f, g + 5 * D, g + 6 * D, xres, xres, (bf16_t*)(ws + WS_XN), w.gw, w.NGW, w.lane); }
        { KA ka; unsigned char* ws = ka.ws(); EpiBf E{(bf16_t*)(ws + WS_E), D}; run_gemm(lds, (const bf16_t*)(ws + WS_PB), (const bf16_t*)(ws + WS_WPROJ), M, D, PLE, E); }
    }
    SEAM();
    if (EN(10)) { KA ka; unsigned char* ws = ka.ws(); EpiGate E{(float*)(ws + WS_Y), (const bf16_t*)(ws + WS_E)}; run_gemm(lds, (const bf16_t*)(ws + WS_XN), (const bf16_t*)(ws + WS_WGATE), M, D, D, E); }
    SEAM();
    if (EN(11)) {
        { KA ka; unsigned char* ws = ka.ws(); const WaveId w = wave_id(); const float* g = ka.in(2) + (size_t)LAYER * 8 * D; float* xres = ka.out();
          rows_phase((const float*)(ws + WS_Y), 1.0f, g + 7 * D, (LAYER + 1 < DEPTH) ? g + 8 * D : nullptr, xres, xres, (bf16_t*)(ws + WS_XN), w.gw, w.NGW, w.lane); }
        if (LAYER + 1 < DEPTH) { KA ka; const WaveId w = wave_id(); LayerW L; layer_weights(ka, LAYER + 1, L); convert_weights(L, ka.ws(), (LAS float*)(lds + w.wave * 16384), w.gw, w.NGW, w.lane); }
    }
}

__global__ void __launch_bounds__(NWAVES * 64, 2) fwd_megakernel(Args args) {
    extern __shared__ __attribute__((aligned(16))) unsigned char lds_raw[];
    LAS unsigned char* lds = (LAS unsigned char*)lds_raw;
    cg::grid_group grid = cg::this_grid();
    {
        { KA ka; const WaveId w = wave_id(); LayerW L; layer_weights(ka, 0, L); convert_weights(L, ka.ws(), (LAS float*)(lds + w.wave * 16384), w.gw, w.NGW, w.lane); }
        { KA ka; const WaveId w = wave_id(); rows_phase(nullptr, 0.f, nullptr, ka.in(2), ka.in(0), ka.out(), (bf16_t*)(ka.ws() + WS_XN), w.gw, w.NGW, w.lane); }
    }
    SEAM();
    layer_body<0>(lds, grid);
    SEAM();
    layer_body<1>(lds, grid);
}

extern "C" void kernel_launch(void* const* d_in, const int* in_sizes, int n_in, void* d_out, int out_size, void* d_ws, size_t ws_size, hipStream_t stream) {
    static int grid = 0;
    if (grid == 0) {
        if (n_in != 15 || in_sizes[0] != M * D || out_size != M * D || ws_size < WS_END) { fprintf(stderr, "kernel_launch: unexpected shapes (n_in %d, in0 %d, out %d, ws %zu)\n", n_in, n_in > 0 ? in_sizes[0] : -1, out_size, ws_size); grid = -1; return; }
        int dev = 0, cus = 0, per_cu = 0;
        if (hipGetDevice(&dev) != hipSuccess || hipDeviceGetAttribute(&cus, hipDeviceAttributeMultiprocessorCount, dev) != hipSuccess) { grid = -1; return; }
        if (hipFuncSetAttribute((const void*)fwd_megakernel, hipFuncAttributeMaxDynamicSharedMemorySize, LDS_BYTES) != hipSuccess) { fprintf(stderr, "kernel_launch: hipFuncSetAttribute failed\n"); grid = -1; return; }
        if (hipOccupancyMaxActiveBlocksPerMultiprocessor(&per_cu, (const void*)fwd_megakernel, NWAVES * 64, LDS_BYTES) != hipSuccess || per_cu < 1) { fprintf(stderr, "kernel_launch: occupancy query says %d\n", per_cu); per_cu = 1; }
        (void)hipGetLastError();
        grid = cus;
    }
    if (grid < 0) return;
    Args a{};
    for (int i = 0; i < 15; ++i) a.in[i] = (const float*)d_in[i];
    a.out = (float*)d_out; a.ws = (unsigned char*)d_ws;
    void* kargs[] = {&a};
    hipError_t e = hipLaunchCooperativeKernel((const void*)fwd_megakernel, dim3(grid), dim3(NWAVES * 64), kargs, LDS_BYTES, stream);
    if (e != hipSuccess) fprintf(stderr, "kernel_launch: cooperative launch failed: %s (grid %d)\n", hipGetErrorString(e), grid);
}
```

```cpp
#include <hip/hip_runtime.h>
#include <cstdio>
#include <cstdint>
namespace pg8 {
#define PG8_LAS __attribute__((address_space(3)))
typedef unsigned short bf16_t;
typedef short bf16x8 __attribute__((ext_vector_type(8)));
typedef float f32x4 __attribute__((ext_vector_type(4)));
typedef unsigned u32x4 __attribute__((ext_vector_type(4)));
constexpr int BM = 256, BK = 64, HALF = 128, HTB = HALF * BK * 2  , STAGE_BYTES = 8 * HTB, NXCD = 8, WGM = 8;

__host__ __device__ __forceinline__ int lds_byte(int r, int c) { const int st = (r >> 4) * 2 + (c >> 5), rr = r & 15, cc = c & 31, ob = rr * 64 + cc * 2; return st * 1024 + (ob ^ (((ob >> 9) & 1) << 5)); }
__host__ __device__ __forceinline__ void stage_rc(int b, int& R, int& C) { const int st = b / 1024, sb = b % 1024, swz = sb ^ (((sb >> 9) & 1) << 5); R = (st >> 1) * 16 + swz / 64; C = (st & 1) * 32 + (swz % 64) / 2; }
__host__ __device__ __forceinline__ int perm32(int rho) { const int n = rho >> 4, i = rho & 15; return 8 * (i >> 2) + 4 * n + (i & 3); }

struct Unit { int pm, pn; };
struct Gemm { const bf16_t* A; const bf16_t* Bt; int M, N, K; };

struct StaticOrder {
    int nM, nN, nwg, G, c;
    __host__ __device__ void init(int M, int N, int G_, int c_) { nM = M / BM; nN = N / BM; nwg = nM * nN; G = G_; c = c_; }
    __host__ __device__ bool next(int i, Unit& u) const {
        const long L = (long)i * G + c; if (L >= nwg) return false;
        int wgid = (int)L; { const int q = nwg / NXCD, r = nwg % NXCD, xcd = wgid % NXCD, off = wgid / NXCD; wgid = (xcd < r ? xcd * (q + 1) : r * (q + 1) + (xcd - r) * q) + off; }
        const int nig = WGM * nN, gid = wgid / nig, fm = gid * WGM, gsz = (nM - fm) < WGM ? (nM - fm) : WGM;
        u.pm = fm + ((wgid % nig) % gsz); u.pn = (wgid % nig) / gsz; return true;
    }
    __device__ __forceinline__ void a_ready(const Unit&) const {}
    __device__ __forceinline__ void done(const Unit&) const {}
};

__device__ __forceinline__ unsigned cvt_pk_bf16(float lo, float hi) { unsigned r; asm volatile("v_cvt_pk_bf16_f32 %0, %1, %2" : "=v"(r) : "v"(lo), "v"(hi)); return r; }
typedef float f32x2 __attribute__((ext_vector_type(2)));
__device__ __forceinline__ f32x2 gelu_pk(f32x2 v) {
    const f32x2 av = __builtin_elementwise_abs(v), d = av * 0.2316418882f + 1.0f;
    f32x2 t; t.x = __builtin_amdgcn_rcpf(d.x); t.y = __builtin_amdgcn_rcpf(d.y);
    f32x2 q = t * 0.5307027145f + (-0.7265760135f); q = q * t + 0.7107068705f; q = q * t + (-0.142248368f); q = q * t + 0.127414796f; q = q * t;
    const f32x2 s = (v * v) * (-0.72134752044f);
    f32x2 e; e.x = __builtin_amdgcn_exp2f(s.x); e.y = __builtin_amdgcn_exp2f(s.y);
    const f32x2 m = v * (q * e), r = v - m;
    f32x2 o; o.x = v.x < 0.f ? m.x : r.x; o.y = v.y < 0.f ? m.y : r.y; return o;
}

template <int ACT  > struct EpiBf16 {
    static constexpr bool PERM = true, AFTER_DRAIN = false; static_assert(ACT == 0 || ACT == 1, "EpiBf16: ACT is 0 (none) or 1 (gelu_pk)");
    bf16_t* O; int ldc; const float* bias; int split_cols; size_t split_stride; float scale0;
    __device__ __forceinline__ void operator()(const f32x4 (&acc)[2][2][4][2], const Unit& u, int wr, int wc, int fr, int fq) const {
        const int row0 = u.pm * BM + wr * 64 + fr; int colt = u.pn * BM; bf16_t* base = O;
        float sc = 1.f; if (split_cols) { const int t = colt / split_cols; base += (size_t)t * split_stride; colt -= t * split_cols; if (t == 0) sc = scale0; }
        const int col0 = colt + wc * 32 + 8 * fq, bcol0 = u.pn * BM + wc * 32 + 8 * fq;
        f32x4 bv[2][2];
#pragma unroll
        for (int bj = 0; bj < 2; ++bj)
#pragma unroll
            for (int n = 0; n < 2; ++n) bv[bj][n] = bias ? *(const f32x4*)(bias + bcol0 + bj * HALF + 4 * n) : (f32x4){0.f, 0.f, 0.f, 0.f};
#pragma unroll
        for (int ai = 0; ai < 2; ++ai)
#pragma unroll
            for (int m = 0; m < 4; ++m) { bf16_t* rowp = base + (size_t)(row0 + ai * HALF + m * 16) * ldc + col0;
#pragma unroll
                for (int bj = 0; bj < 2; ++bj) { f32x4 v0 = acc[ai][bj][m][0] + bv[bj][0], v1 = acc[ai][bj][m][1] + bv[bj][1];
                    if (ACT == 1) { f32x2 a = gelu_pk((f32x2){v0[0], v0[1]}), b = gelu_pk((f32x2){v0[2], v0[3]}), c = gelu_pk((f32x2){v1[0], v1[1]}), d = gelu_pk((f32x2){v1[2], v1[3]});
                        v0 = (f32x4){a.x, a.y, b.x, b.y}; v1 = (f32x4){c.x, c.y, d.x, d.y}; }
                    v0 = v0 * sc; v1 = v1 * sc; u32x4 w; w.x = cvt_pk_bf16(v0[0], v0[1]); w.y = cvt_pk_bf16(v0[2], v0[3]); w.z = cvt_pk_bf16(v1[0], v1[1]); w.w = cvt_pk_bf16(v1[2], v1[3]);
                    *(u32x4*)(rowp + bj * HALF) = w; } }
    }
};

struct PanelStats {
    unsigned* xbuf;
    unsigned* cnt;
    unsigned* tmo;
    int ntn; float eps;
    unsigned code;
    __device__ __forceinline__ bool run(const f32x4 (&v)[2][2][4][2], const Unit& u, int wr, int wc, int fr, int fq, PG8_LAS unsigned char* lds, int wid, int lane) const {
        typedef float f32x2v __attribute__((ext_vector_type(2)));
        PG8_LAS f32x2v* P = (PG8_LAS f32x2v*)lds;
        PG8_LAS f32x2v* S = (PG8_LAS f32x2v*)(lds + 8192);
        PG8_LAS unsigned* flag = (PG8_LAS unsigned*)(lds + 8192 + 2048);
#pragma unroll
        for (int ai = 0; ai < 2; ++ai)
#pragma unroll
            for (int m = 0; m < 4; ++m) {
                float s = 0.f;
#pragma unroll
                for (int bj = 0; bj < 2; ++bj)
#pragma unroll
                    for (int n = 0; n < 2; ++n) { const f32x4 x = v[ai][bj][m][n]; s += (x[0] + x[1]) + (x[2] + x[3]); }
                s += __shfl_xor(s, 16); s += __shfl_xor(s, 32);
                const float mw = s * (1.0f / 64.0f); float q = 0.f;
#pragma unroll
                for (int bj = 0; bj < 2; ++bj)
#pragma unroll
                    for (int n = 0; n < 2; ++n) { const f32x4 d = v[ai][bj][m][n] - mw; q += (d[0] * d[0] + d[1] * d[1]) + (d[2] * d[2] + d[3] * d[3]); }
                q += __shfl_xor(q, 16); q += __shfl_xor(q, 32);
                if (fq == 0) P[(ai * HALF + wr * 64 + m * 16 + fr) * 4 + wc] = (f32x2v){mw, q};
            }
        asm volatile("s_waitcnt lgkmcnt(0)" ::: "memory"); __builtin_amdgcn_s_barrier(); asm volatile("" ::: "memory");
#if defined(BROKEN_EXCHANGE_NO_WAIT)
#warning BROKEN CONTROL BUILD: the row-statistics exchange does not wait; results are wrong by design
        if (blockIdx.x >= 64) { const long long t0_ = clock64(); while (clock64() - t0_ < 60000) __builtin_amdgcn_s_sleep(8); }
#endif
        const int row = wid * 32 + (lane & 31);
        if (lane < 32) {
            const f32x2v a = P[row * 4 + 0], b = P[row * 4 + 1], c = P[row * 4 + 2], d = P[row * 4 + 3];
            const float mt = (a.x + b.x + c.x + d.x) * 0.25f;
            const float da = a.x - mt, db = b.x - mt, dc = c.x - mt, dd = d.x - mt;
            const float m2 = (a.y + b.y) + (c.y + d.y) + 64.0f * ((da * da + db * db) + (dc * dc + dd * dd));
            unsigned long long* slot = (unsigned long long*)xbuf + ((size_t)(u.pm * BM + row) * 4 + u.pn);
            __hip_atomic_store(slot, ((unsigned long long)__float_as_uint(m2) << 32) | __float_as_uint(mt), __ATOMIC_RELAXED, __HIP_MEMORY_SCOPE_AGENT);
        }
        asm volatile("s_waitcnt vmcnt(0)" ::: "memory");
        if (lane == 0) __hip_atomic_fetch_add(cnt + 64 * u.pm, 1u, __ATOMIC_RELAXED, __HIP_MEMORY_SCOPE_AGENT);
        if (wid == 0) {
            bool dead = false; const unsigned long long t0 = __builtin_amdgcn_s_memrealtime(); const unsigned want = 8u * (unsigned)ntn;
            for (;;) {
#if defined(BROKEN_EXCHANGE_NO_WAIT)
                break;
#endif
                if ((unsigned)__builtin_amdgcn_readfirstlane(__hip_atomic_load(cnt + 64 * u.pm, __ATOMIC_RELAXED, __HIP_MEMORY_SCOPE_AGENT)) >= want) break;
                if (__builtin_amdgcn_s_memrealtime() - t0 > 2000000ull) {
                    if (lane == 0) { unsigned expect = 0u; __hip_atomic_compare_exchange_strong(tmo + 1, &expect, code | (unsigned)(u.pm & 0xff), __ATOMIC_RELAXED, __ATOMIC_RELAXED, __HIP_MEMORY_SCOPE_AGENT);
                                     __hip_atomic_store(tmo, 1u, __ATOMIC_RELAXED, __HIP_MEMORY_SCOPE_AGENT); }
                    dead = true; break; }
                __builtin_amdgcn_s_sleep(2);
            }
            __builtin_amdgcn_fence(__ATOMIC_ACQUIRE, "agent");
            if (lane == 0) flag[0] = dead ? 1u : 0u;
        }
        asm volatile("s_waitcnt vmcnt(0) lgkmcnt(0)" ::: "memory"); __builtin_amdgcn_s_barrier(); asm volatile("" ::: "memory");
        const bool bad = flag[0] != 0u;
        if (lane < 32) {
            const unsigned long long* slot = (const unsigned long long*)xbuf + (size_t)(u.pm * BM + row) * 4; float mt[4], m2[4]; float ms = 0.f;
#pragma unroll
            for (int t = 0; t < 4; ++t) { if (t < ntn) { const unsigned long long w = __hip_atomic_load(slot + t, __ATOMIC_RELAXED, __HIP_MEMORY_SCOPE_AGENT); mt[t] = __uint_as_float((unsigned)w); m2[t] = __uint_as_float((unsigned)(w >> 32)); } else { mt[t] = 0.f; m2[t] = 0.f; } ms += mt[t]; }
            const float mean = ms / (float)ntn; float q = 0.f;
#pragma unroll
            for (int t = 0; t < 4; ++t) if (t < ntn) { const float dm = mt[t] - mean; q += m2[t] + 256.0f * dm * dm; }
            S[row] = (f32x2v){mean, 1.0f / sqrtf(q / (256.0f * (float)ntn) + eps)};
        }
        asm volatile("s_waitcnt lgkmcnt(0)" ::: "memory"); __builtin_amdgcn_s_barrier(); asm volatile("" ::: "memory");
        return bad;
    }
};
struct EpiLnRes {
    static constexpr bool PERM = false, AFTER_DRAIN = true;
    const float* base; float* out; int ldc; const float* bias; PanelStats st; unsigned poison;
    __device__ __forceinline__ void fused(f32x4 (&acc)[2][2][4][2], const Unit& u, int wr, int wc, int fr, int fq, PG8_LAS unsigned char* lds, int wid, int lane) const {
        typedef float f32x2v __attribute__((ext_vector_type(2)));
        const PG8_LAS f32x2v* S = (const PG8_LAS f32x2v*)(lds + 8192);
        const int col0 = u.pn * BM + wc * 32 + 4 * fq;
#pragma unroll
        for (int bj = 0; bj < 2; ++bj)
#pragma unroll
            for (int n = 0; n < 2; ++n) { const f32x4 bv = bias ? *(const f32x4*)(bias + col0 + bj * HALF + n * 16) : (f32x4){0.f, 0.f, 0.f, 0.f};
#pragma unroll
                for (int ai = 0; ai < 2; ++ai)
#pragma unroll
                    for (int m = 0; m < 4; ++m) acc[ai][bj][m][n] += bv; }
        f32x4 pre[4][2][2];
#pragma unroll
        for (int m = 0; m < 4; ++m) { const size_t off = (size_t)(u.pm * BM + wr * 64 + m * 16 + fr) * ldc + col0;
#pragma unroll
            for (int bj = 0; bj < 2; ++bj)
#pragma unroll
                for (int n = 0; n < 2; ++n) pre[m][bj][n] = *(const f32x4*)(base + off + bj * HALF + n * 16); }
        const bool bad = st.run(acc, u, wr, wc, fr, fq, lds, wid, lane) || poison != 0u;
        const float qnan = __builtin_nanf("");
#pragma unroll
        for (int ai = 0; ai < 2; ++ai)
#pragma unroll
            for (int m = 0; m < 4; ++m) { const int r = ai * HALF + wr * 64 + m * 16 + fr; const f32x2v sr = S[r]; const size_t off = (size_t)(u.pm * BM + r) * ldc + col0;
#pragma unroll
                for (int bj = 0; bj < 2; ++bj)
#pragma unroll
                    for (int n = 0; n < 2; ++n) { const f32x4 bs = ai == 0 ? pre[m][bj][n] : *(const f32x4*)(base + off + bj * HALF + n * 16); f32x4 o = bs + (acc[ai][bj][m][n] - sr.x) * sr.y;
                        if (bad) o = (f32x4){qnan, qnan, qnan, qnan}; *(f32x4*)(out + off + bj * HALF + n * 16) = o; }
                if (m & 1) asm volatile("" ::: "memory"); }
    }
};
struct EpiLnResLn {
    static constexpr bool PERM = false, AFTER_DRAIN = true;
    const float* base; float* out; bf16_t* xn; int ldc; const float* bias; PanelStats st1, st2; unsigned poison;
    __device__ __forceinline__ void fused(f32x4 (&acc)[2][2][4][2], const Unit& u, int wr, int wc, int fr, int fq, PG8_LAS unsigned char* lds, int wid, int lane) const {
        typedef float f32x2v __attribute__((ext_vector_type(2))); typedef unsigned u32x2v __attribute__((ext_vector_type(2)));
        const PG8_LAS f32x2v* S = (const PG8_LAS f32x2v*)(lds + 8192);
        const int col0 = u.pn * BM + wc * 32 + 4 * fq;
#pragma unroll
        for (int bj = 0; bj < 2; ++bj)
#pragma unroll
            for (int n = 0; n < 2; ++n) { const f32x4 bv = bias ? *(const f32x4*)(bias + col0 + bj * HALF + n * 16) : (f32x4){0.f, 0.f, 0.f, 0.f};
#pragma unroll
                for (int ai = 0; ai < 2; ++ai)
#pragma unroll
                    for (int m = 0; m < 4; ++m) acc[ai][bj][m][n] += bv; }
        bool bad = st1.run(acc, u, wr, wc, fr, fq, lds, wid, lane) || poison != 0u;
        const float qnan = __builtin_nanf("");
#pragma unroll
        for (int ai = 0; ai < 2; ++ai)
#pragma unroll
            for (int m = 0; m < 4; ++m) { const int r = ai * HALF + wr * 64 + m * 16 + fr; const f32x2v sr = S[r]; const size_t off = (size_t)(u.pm * BM + r) * ldc + col0;
#pragma unroll
                for (int bj = 0; bj < 2; ++bj)
#pragma unroll
                    for (int n = 0; n < 2; ++n) { const f32x4 bs = *(const f32x4*)(base + off + bj * HALF + n * 16); acc[ai][bj][m][n] = bs + (acc[ai][bj][m][n] - sr.x) * sr.y; }
                asm volatile("" : "+v"(acc[ai][0][m][0]), "+v"(acc[ai][0][m][1]), "+v"(acc[ai][1][m][0]), "+v"(acc[ai][1][m][1]));
                if (m & 1) asm volatile("" ::: "memory"); }
        const bool bad1 = bad;
        bad = st2.run(acc, u, wr, wc, fr, fq, lds, wid, lane) || bad;
#pragma unroll
        for (int ai = 0; ai < 2; ++ai)
#pragma unroll
            for (int m = 0; m < 4; ++m) { const int r = ai * HALF + wr * 64 + m * 16 + fr; const f32x2v sr = S[r]; const size_t off = (size_t)(u.pm * BM + r) * ldc + col0;
#pragma unroll
                for (int bj = 0; bj < 2; ++bj)
#pragma unroll
                    for (int n = 0; n < 2; ++n) { const f32x4 x1 = acc[ai][bj][m][n]; *(f32x4*)(out + off + bj * HALF + n * 16) = bad1 ? (f32x4){qnan, qnan, qnan, qnan} : x1;
                        const f32x4 o = (x1 - sr.x) * sr.y; u32x2v w; w.x = cvt_pk_bf16(o[0], o[1]); w.y = cvt_pk_bf16(o[2], o[3]);
                        if (bad) { w.x = 0x7fc07fc0u; w.y = 0x7fc07fc0u; } *(u32x2v*)(xn + off + bj * HALF + n * 16) = w; }
                asm volatile("" ::: "memory"); }
    }
};

template <class Epi, class Sched, bool ALIGN_EPI = false, bool SP2 = false>
__device__ __forceinline__ void gemm_phase(PG8_LAS unsigned char* lds, const Gemm g, const Sched& S, const Epi& E) {
    int tid_ = threadIdx.x; asm volatile("" : "+v"(tid_));
    const int tid = tid_, wid = __builtin_amdgcn_readfirstlane(tid >> 6), lane = tid & 63, wr = wid >> 2, wc = wid & 3, fr = lane & 15, fq = lane >> 4;
    const int K = g.K, nt = K / BK;
    unsigned voffA[2], voffB[2];
#pragma unroll
    for (int i = 0; i < 2; ++i) { int R, C; stage_rc(tid * 16 + i * 8192, R, C); const int Rb = Epi::PERM ? ((R & ~31) + perm32(R & 31)) : R;
        voffA[i] = (unsigned)(R * K + C) * 2u; voffB[i] = (unsigned)(Rb * K + C) * 2u; }
    const size_t kstep = (size_t)(BK * 2);
    const size_t hstep = (size_t)HALF * K * 2;
    const size_t tstep = 2 * hstep;
    const unsigned ldsw = (unsigned)wid * 1024u;
    const int aoff = lds_byte(wr * 64 + fr, fq * 8), boff = lds_byte(wc * 32 + fr, fq * 8);
#define PG8_SA(b, h) (((b) * 2 + (h)) * HTB)
#define PG8_SB(b, h) ((4 + (b) * 2 + (h)) * HTB)
#define PG8_STAGE(bufoff, gbase, voff) do { _Pragma("unroll") for (int _i = 0; _i < 2; ++_i) \
        __builtin_amdgcn_global_load_lds((const unsigned*)((const char*)(gbase) + (voff)[_i]), (PG8_LAS unsigned*)(lds + (bufoff) + ldsw + _i * 8192), 16, 0, 0); } while (0)
#define PG8_LDA(dst, b, h) do { _Pragma("unroll") for (int m = 0; m < 4; ++m) _Pragma("unroll") for (int k = 0; k < 2; ++k) dst[m][k] = *(const PG8_LAS bf16x8*)(lds + PG8_SA(b, h) + aoff + m * 2048 + k * 1024); } while (0)
#define PG8_LDB(dst, b, h) do { _Pragma("unroll") for (int n = 0; n < 2; ++n) _Pragma("unroll") for (int k = 0; k < 2; ++k) dst[n][k] = *(const PG8_LAS bf16x8*)(lds + PG8_SB(b, h) + boff + n * 2048 + k * 1024); } while (0)
#define PG8_MMA(ai, bj, At, Bt) do { __builtin_amdgcn_s_setprio(1); _Pragma("unroll") for (int m = 0; m < 4; ++m) _Pragma("unroll") for (int n = 0; n < 2; ++n) _Pragma("unroll") for (int k = 0; k < 2; ++k) \
        acc[ai][bj][m][n] = __builtin_amdgcn_mfma_f32_16x16x32_bf16(Bt[n][k], At[m][k], acc[ai][bj][m][n], 0, 0, 0); __builtin_amdgcn_s_setprio(0); } while (0)
#define PG8_WAIT_V(n) asm volatile("s_waitcnt vmcnt(" #n ")" ::: "memory")
#define PG8_WAIT_L(n) asm volatile("s_waitcnt lgkmcnt(" #n ")" ::: "memory")
#define PG8_BAR __builtin_amdgcn_s_barrier()
#define PG8_SCHED __builtin_amdgcn_sched_barrier(0)
    Unit cur, nxt; int ui = 0;
    if (!S.next(0, cur)) return;
    f32x4 acc[2][2][4][2];
#pragma unroll
    for (int a = 0; a < 2; ++a)
#pragma unroll
        for (int b = 0; b < 2; ++b)
#pragma unroll
            for (int m = 0; m < 4; ++m)
#pragma unroll
                for (int n = 0; n < 2; ++n) acc[a][b][m][n] = (f32x4){0.f, 0.f, 0.f, 0.f};
    bf16x8 At[4][2], B0[2][2], B1[2][2];
    const char* cA = (const char*)g.A + (size_t)cur.pm * tstep; const char* cB = (const char*)g.Bt + (size_t)cur.pn * tstep;
    S.a_ready(cur);
    if constexpr (SP2) {
        PG8_STAGE(PG8_SB(0, 0), cB, voffB); PG8_STAGE(PG8_SB(0, 1), cB + hstep, voffB); PG8_STAGE(PG8_SA(0, 0), cA, voffA); PG8_STAGE(PG8_SA(0, 1), cA + hstep, voffA);
        if (wr == 1) PG8_BAR;
        PG8_WAIT_V(2); PG8_BAR;
        PG8_STAGE(PG8_SB(1, 0), cB + kstep, voffB); PG8_STAGE(PG8_SA(1, 0), cA + kstep, voffA); PG8_STAGE(PG8_SB(1, 1), cB + hstep + kstep, voffB);
        PG8_WAIT_V(6); PG8_BAR;
    } else {
        PG8_STAGE(PG8_SB(0, 0), cB, voffB); PG8_STAGE(PG8_SA(0, 0), cA, voffA); PG8_STAGE(PG8_SB(0, 1), cB + hstep, voffB); PG8_STAGE(PG8_SA(0, 1), cA + hstep, voffA);
        if (wr == 1) PG8_BAR;
        PG8_WAIT_V(4); PG8_BAR;
        PG8_STAGE(PG8_SB(1, 0), cB + kstep, voffB); PG8_STAGE(PG8_SA(1, 0), cA + kstep, voffA); PG8_STAGE(PG8_SB(1, 1), cB + hstep + kstep, voffB);
        PG8_WAIT_V(6); PG8_BAR;
    }
    for (;;) {
        const bool has_next = S.next(ui + 1, nxt);
        const char* nA = has_next ? (const char*)g.A + (size_t)nxt.pm * tstep : cA; const char* nB = has_next ? (const char*)g.Bt + (size_t)nxt.pn * tstep : cB;
        for (int t = 0; t < nt; t += 2) {
            const bool last = (t == nt - 2);
            const char* a1 = cA + (size_t)(t + 1) * kstep;
            const char* a2 = last ? nA : cA + (size_t)(t + 2) * kstep; const char* b2 = last ? nB : cB + (size_t)(t + 2) * kstep;
            const char* a3 = a2 + kstep; const char* b3 = b2 + kstep;
            if (last && has_next) S.a_ready(nxt);
            if constexpr (SP2) {
            PG8_LDB(B0, 0, 0); PG8_LDB(B1, 0, 1); PG8_SCHED; PG8_LDA(At, 0, 0); PG8_STAGE(PG8_SA(1, 1), a1 + hstep, voffA);
            PG8_WAIT_V(8); PG8_WAIT_L(0); PG8_BAR; PG8_MMA(0, 0, At, B0); PG8_MMA(0, 1, At, B1); PG8_BAR; PG8_SCHED;
            PG8_LDA(At, 0, 1); PG8_STAGE(PG8_SB(0, 0), b2, voffB); PG8_STAGE(PG8_SB(0, 1), b2 + hstep, voffB); PG8_STAGE(PG8_SA(0, 0), a2, voffA);
            PG8_WAIT_V(8); PG8_WAIT_L(0); PG8_BAR; PG8_MMA(1, 0, At, B0); PG8_MMA(1, 1, At, B1); PG8_BAR; PG8_SCHED;
            PG8_LDB(B0, 1, 0); PG8_LDB(B1, 1, 1); PG8_SCHED; PG8_LDA(At, 1, 0); PG8_STAGE(PG8_SA(0, 1), a2 + hstep, voffA);
            PG8_WAIT_V(8); PG8_WAIT_L(0); PG8_BAR; PG8_MMA(0, 0, At, B0); PG8_MMA(0, 1, At, B1); PG8_BAR; PG8_SCHED;
            PG8_LDA(At, 1, 1); PG8_STAGE(PG8_SB(1, 0), b3, voffB); PG8_STAGE(PG8_SB(1, 1), b3 + hstep, voffB); PG8_STAGE(PG8_SA(1, 0), a3, voffA);
            PG8_WAIT_V(8); PG8_WAIT_L(0); PG8_BAR; PG8_MMA(1, 0, At, B0); PG8_MMA(1, 1, At, B1); PG8_BAR; PG8_SCHED;
            } else {
            PG8_LDB(B0, 0, 0); PG8_SCHED; PG8_LDA(At, 0, 0); PG8_STAGE(PG8_SA(1, 1), a1 + hstep, voffA);
            PG8_WAIT_L(8); PG8_BAR; PG8_WAIT_L(0); PG8_MMA(0, 0, At, B0); PG8_BAR; PG8_SCHED;
            PG8_LDB(B1, 0, 1); PG8_STAGE(PG8_SB(0, 0), b2, voffB);
            PG8_BAR; PG8_WAIT_L(0); PG8_MMA(0, 1, At, B1); PG8_BAR;
            PG8_LDA(At, 0, 1); PG8_STAGE(PG8_SA(0, 0), a2, voffA);
            PG8_BAR; PG8_WAIT_L(0); PG8_MMA(1, 0, At, B0); PG8_BAR; PG8_SCHED;
            PG8_STAGE(PG8_SB(0, 1), b2 + hstep, voffB);
            PG8_WAIT_V(6); PG8_BAR; PG8_MMA(1, 1, At, B1); PG8_BAR;
            PG8_LDB(B0, 1, 0); PG8_SCHED; PG8_LDA(At, 1, 0); PG8_STAGE(PG8_SA(0, 1), a2 + hstep, voffA);
            PG8_WAIT_L(8); PG8_BAR; PG8_WAIT_L(0); PG8_MMA(0, 0, At, B0); PG8_BAR; PG8_SCHED;
            PG8_LDB(B1, 1, 1); PG8_STAGE(PG8_SB(1, 0), b3, voffB);
            PG8_BAR; PG8_WAIT_L(0); PG8_MMA(0, 1, At, B1); PG8_BAR;
            PG8_LDA(At, 1, 1); PG8_STAGE(PG8_SA(1, 0), a3, voffA);
            PG8_BAR; PG8_WAIT_L(0); PG8_MMA(1, 0, At, B0); PG8_BAR; PG8_SCHED;
            PG8_STAGE(PG8_SB(1, 1), b3 + hstep, voffB);
            PG8_WAIT_V(6); PG8_BAR; PG8_MMA(1, 1, At, B1); PG8_BAR;
            }
        }
        if constexpr (ALIGN_EPI) { if (wr == 0) PG8_BAR; }
        if constexpr (!Epi::AFTER_DRAIN) { E(acc, cur, wr, wc, fr, fq); S.done(cur); }
        if (!has_next) break;
#pragma unroll
        for (int a = 0; a < 2; ++a)
#pragma unroll
            for (int b = 0; b < 2; ++b)
#pragma unroll
                for (int m = 0; m < 4; ++m)
#pragma unroll
                    for (int n = 0; n < 2; ++n) acc[a][b][m][n] = (f32x4){0.f, 0.f, 0.f, 0.f};
        cur = nxt; cA = nA; cB = nB; ++ui;
        if constexpr (ALIGN_EPI) { if (wr == 1) PG8_BAR; }
    }
    PG8_WAIT_V(0);
    if constexpr (!ALIGN_EPI) { if (wr == 0) PG8_BAR; }
    PG8_BAR;
    if constexpr (Epi::AFTER_DRAIN) { E.fused(acc, cur, wr, wc, fr, fq, lds, wid, lane); S.done(cur); }
#undef PG8_SA
#undef PG8_SB
#undef PG8_STAGE
#undef PG8_LDA
#undef PG8_LDB
#undef PG8_MMA
#undef PG8_WAIT_V
#undef PG8_WAIT_L
#undef PG8_BAR
#undef PG8_SCHED
}
}

#ifndef PG8_SP2
#define PG8_SP2 true
#endif
#ifndef PG8_ALIGN
#define PG8_ALIGN true
#endif
#include <hip/hip_cooperative_groups.h>
namespace cg = cooperative_groups;

constexpr int BATCH = 8, SEQ = 2048, D = 1024, M = BATCH * SEQ, FF = 2816, PLE = 256, DEPTH = 2;
constexpr float EPS = 1e-6f;
constexpr float LOG2E = 1.4426950408889634f;
constexpr int NWAVES = 8;
constexpr int LDS_BYTES = 147456;
#define LAS __attribute__((address_space(3)))
typedef unsigned short bf16_t;
typedef float f32x4 __attribute__((ext_vector_type(4)));
typedef unsigned u32x4 __attribute__((ext_vector_type(4)));
typedef unsigned u32x2 __attribute__((ext_vector_type(2)));
typedef short bf16x8 __attribute__((ext_vector_type(8)));
typedef float f32x16 __attribute__((ext_vector_type(16)));

constexpr size_t MiB = 1u << 20;
constexpr size_t WS_CTL = 0;
constexpr size_t WS_W1IN = 1 * MiB;
constexpr size_t WS_W1OUT = WS_W1IN + (size_t)2 * FF * D * 2;
constexpr size_t WS_W2IN = WS_W1OUT + (size_t)D * FF * 2;
constexpr size_t WS_W2OUT = WS_W2IN + (size_t)2 * FF * D * 2;
constexpr size_t WS_WQKV = WS_W2OUT + (size_t)D * FF * 2;
constexpr size_t WS_WO = WS_WQKV + (size_t)3 * D * D * 2;
constexpr size_t WS_WPROJ = WS_WO + (size_t)D * D * 2;
constexpr size_t WS_WGATE = WS_WPROJ + (size_t)D * PLE * 2;
constexpr size_t WS_WEND = WS_WGATE + (size_t)D * D * 2;
static_assert(WS_WEND <= 48 * MiB, "weights");
constexpr size_t WS_Y = 48 * MiB;
constexpr size_t WS_QK = 112 * MiB;
constexpr size_t WS_VT = 176 * MiB;
constexpr size_t WS_H = 112 * MiB;
constexpr size_t WS_E = 112 * MiB;
constexpr size_t WS_XN = 208 * MiB;
constexpr size_t WS_PB = 240 * MiB;
constexpr size_t WS_END = 248 * MiB;

__device__ __forceinline__ unsigned pk2bf(float lo, float hi) {
    typedef float f2 __attribute__((ext_vector_type(2))); typedef __bf16 b2 __attribute__((ext_vector_type(2)));
    f2 v = {lo, hi}; b2 b = __builtin_convertvector(v, b2); return __builtin_bit_cast(unsigned, b);
}
__device__ __forceinline__ float bf2f(unsigned short h) { return __builtin_bit_cast(float, (unsigned)h << 16); }
__device__ __forceinline__ float wave_sum(float v) {
#pragma unroll
    for (int o = 1; o < 64; o <<= 1) v += __shfl_xor(v, o);
    return v;
}
__device__ __forceinline__ float fast_sigmoid(float x) { return __builtin_amdgcn_rcpf(1.0f + __builtin_amdgcn_exp2f(-x * LOG2E)); }

struct EpiF32 {
    static constexpr bool PERM = false, AFTER_DRAIN = false;
    float* out; int ldc;
    __device__ __forceinline__ void operator()(const pg8::f32x4 (&acc)[2][2][4][2], const pg8::Unit& u, int wr, int wc, int fr, int fq) const {
        const int col0 = u.pn * 256 + wc * 32 + 4 * fq;
#pragma unroll
        for (int ai = 0; ai < 2; ++ai)
#pragma unroll
            for (int m = 0; m < 4; ++m) { float* rowp = out + (size_t)(u.pm * 256 + ai * 128 + wr * 64 + m * 16 + fr) * ldc + col0;
#pragma unroll
                for (int bj = 0; bj < 2; ++bj)
#pragma unroll
                    for (int n = 0; n < 2; ++n) *(pg8::f32x4*)(rowp + bj * 128 + n * 16) = acc[ai][bj][m][n]; }
    }
};
struct EpiBf {
    static constexpr bool PERM = true, AFTER_DRAIN = false;
    bf16_t* out; int ldc;
    __device__ __forceinline__ void operator()(const pg8::f32x4 (&acc)[2][2][4][2], const pg8::Unit& u, int wr, int wc, int fr, int fq) const {
        const int col0 = u.pn * 256 + wc * 32 + 8 * fq;
#pragma unroll
        for (int ai = 0; ai < 2; ++ai)
#pragma unroll
            for (int m = 0; m < 4; ++m) { bf16_t* rowp = out + (size_t)(u.pm * 256 + ai * 128 + wr * 64 + m * 16 + fr) * ldc + col0;
#pragma unroll
                for (int bj = 0; bj < 2; ++bj) { const pg8::f32x4 v0 = acc[ai][bj][m][0], v1 = acc[ai][bj][m][1]; u32x4 w;
                    w.x = pk2bf(v0[0], v0[1]); w.y = pk2bf(v0[2], v0[3]); w.z = pk2bf(v1[0], v1[1]); w.w = pk2bf(v1[2], v1[3]);
                    *(u32x4*)(rowp + bj * 128) = w; } }
    }
};
struct EpiSwiglu {
    static constexpr bool PERM = true, AFTER_DRAIN = false;
    bf16_t* out;
    __device__ __forceinline__ void operator()(const pg8::f32x4 (&acc)[2][2][4][2], const pg8::Unit& u, int wr, int wc, int fr, int fq) const {
        const int col0 = u.pn * 128 + wc * 32 + 8 * fq;
#pragma unroll
        for (int ai = 0; ai < 2; ++ai)
#pragma unroll
            for (int m = 0; m < 4; ++m) { bf16_t* rowp = out + (size_t)(u.pm * 256 + ai * 128 + wr * 64 + m * 16 + fr) * FF + col0;
                float h[8];
#pragma unroll
                for (int n = 0; n < 2; ++n)
#pragma unroll
                    for (int j = 0; j < 4; ++j) { const float a = acc[ai][0][m][n][j], b = acc[ai][1][m][n][j]; h[n * 4 + j] = a * fast_sigmoid(a) * b; }
                u32x4 w; w.x = pk2bf(h[0], h[1]); w.y = pk2bf(h[2], h[3]); w.z = pk2bf(h[4], h[5]); w.w = pk2bf(h[6], h[7]);
                *(u32x4*)rowp = w; }
    }
};
struct EpiGate {
    static constexpr bool PERM = false, AFTER_DRAIN = false;
    float* out; const bf16_t* E;
    __device__ __forceinline__ void operator()(const pg8::f32x4 (&acc)[2][2][4][2], const pg8::Unit& u, int wr, int wc, int fr, int fq) const {
        const int col0 = u.pn * 256 + wc * 32 + 4 * fq;
#pragma unroll
        for (int ai = 0; ai < 2; ++ai)
#pragma unroll
            for (int m = 0; m < 4; ++m) { const size_t off = (size_t)(u.pm * 256 + ai * 128 + wr * 64 + m * 16 + fr) * D + col0;
#pragma unroll
                for (int bj = 0; bj < 2; ++bj)
#pragma unroll
                    for (int n = 0; n < 2; ++n) { const u32x2 ev = *(const u32x2*)(E + off + bj * 128 + n * 16); const pg8::f32x4 a = acc[ai][bj][m][n]; pg8::f32x4 o;
                        o[0] = fast_sigmoid(a[0]) * __builtin_bit_cast(float, ev.x << 16); o[1] = fast_sigmoid(a[1]) * __builtin_bit_cast(float, ev.x & 0xffff0000u);
                        o[2] = fast_sigmoid(a[2]) * __builtin_bit_cast(float, ev.y << 16); o[3] = fast_sigmoid(a[3]) * __builtin_bit_cast(float, ev.y & 0xffff0000u);
                        *(pg8::f32x4*)(out + off + bj * 128 + n * 16) = o; } }
    }
};

template <int MODE>
__device__ __forceinline__ void transpose_item(const float* W, int K, int N, bf16_t* WT, LAS float* scr, int item, int lane) {
    const int nblk = N / 32, kb = item / nblk, nb = item % nblk, k0 = 64 * kb, n0 = 32 * nb;
#pragma unroll 8
    for (int i = 0; i < 32; ++i) { const int kk = 2 * i + (lane >> 5); scr[kk * 33 + (lane & 31)] = W[(size_t)(k0 + kk) * N + n0 + (lane & 31)]; }
    asm volatile("s_waitcnt lgkmcnt(0)" ::: "memory");
    int r0 = n0;
    if (MODE == 1) { const int half = n0 >= FF ? 1 : 0; const int j = n0 - half * FF; r0 = (j >> 7) * 256 + half * 128 + (j & 127); }
    const int c = lane & 7;
#pragma unroll
    for (int j = 0; j < 4; ++j) { const int n = (lane >> 3) + 8 * j; const LAS float* s = scr + (8 * c) * 33 + n;
        u32x4 o; o.x = pk2bf(s[0 * 33], s[1 * 33]); o.y = pk2bf(s[2 * 33], s[3 * 33]); o.z = pk2bf(s[4 * 33], s[5 * 33]); o.w = pk2bf(s[6 * 33], s[7 * 33]);
        *(u32x4*)(WT + (size_t)(r0 + n) * K + k0 + 8 * c) = o; }
    asm volatile("s_waitcnt lgkmcnt(0)" ::: "memory");
}

struct LayerW { const float *w1in, *w1out, *w2in, *w2out, *wqkv, *wo, *wproj, *wgate; };
__device__ __forceinline__ void convert_weights(const LayerW& L, unsigned char* ws, LAS float* scr, int gw, int NGW, int lane) {
    constexpr int I_IN = (D / 64) * (2 * FF / 32), I_OUT = (FF / 64) * (D / 32), I_QKV = (D / 64) * (3 * D / 32), I_O = (D / 64) * (D / 32), I_P = (PLE / 64) * (D / 32);
    constexpr int NITEMS = 2 * I_IN + 2 * I_OUT + I_QKV + 2 * I_O + I_P;
    for (int it = gw; it < NITEMS; it += NGW) {
        int r = it;
        if (r < I_IN) { transpose_item<1>(L.w1in, D, 2 * FF, (bf16_t*)(ws + WS_W1IN), scr, r, lane); continue; } r -= I_IN;
        if (r < I_IN) { transpose_item<1>(L.w2in, D, 2 * FF, (bf16_t*)(ws + WS_W2IN), scr, r, lane); continue; } r -= I_IN;
        if (r < I_OUT) { transpose_item<0>(L.w1out, FF, D, (bf16_t*)(ws + WS_W1OUT), scr, r, lane); continue; } r -= I_OUT;
        if (r < I_OUT) { transpose_item<0>(L.w2out, FF, D, (bf16_t*)(ws + WS_W2OUT), scr, r, lane); continue; } r -= I_OUT;
        if (r < I_QKV) { transpose_item<0>(L.wqkv, D, 3 * D, (bf16_t*)(ws + WS_WQKV), scr, r, lane); continue; } r -= I_QKV;
        if (r < I_O) { transpose_item<0>(L.wo, D, D, (bf16_t*)(ws + WS_WO), scr, r, lane); continue; } r -= I_O;
        if (r < I_O) { transpose_item<0>(L.wgate, D, D, (bf16_t*)(ws + WS_WGATE), scr, r, lane); continue; } r -= I_O;
        transpose_item<0>(L.wproj, PLE, D, (bf16_t*)(ws + WS_WPROJ), scr, r, lane);
    }
}

__device__ __forceinline__ void rows_phase(const float* Y, float coef, const float* gpost, const float* gpre, const float* xin, float* xout, bf16_t* XN, int gw, int NGW, int lane) {
    for (int m = gw; m < M; m += NGW) {
        const f32x4* xr = (const f32x4*)(xin + (size_t)m * D) + lane;
        f32x4 xv[4];
#pragma unroll
        for (int j = 0; j < 4; ++j) xv[j] = xr[64 * j];
        if (Y) {
            const f32x4* yr = (const f32x4*)(Y + (size_t)m * D) + lane; f32x4 yv[4]; float ss = 0.f;
#pragma unroll
            for (int j = 0; j < 4; ++j) { yv[j] = yr[64 * j]; ss += (yv[j].x * yv[j].x + yv[j].y * yv[j].y) + (yv[j].z * yv[j].z + yv[j].w * yv[j].w); }
            const float r = coef * __builtin_amdgcn_rsqf(wave_sum(ss) * (1.f / D) + EPS);
#pragma unroll
            for (int j = 0; j < 4; ++j) { const f32x4 g = ((const f32x4*)gpost)[lane + 64 * j]; xv[j] = xv[j] + yv[j] * g * r; }
        }
        if (Y || xin != xout) { f32x4* xo = (f32x4*)(xout + (size_t)m * D) + lane;
#pragma unroll
            for (int j = 0; j < 4; ++j) xo[64 * j] = xv[j]; }
        if (gpre) {
            float ss = 0.f;
#pragma unroll
            for (int j = 0; j < 4; ++j) ss += (xv[j].x * xv[j].x + xv[j].y * xv[j].y) + (xv[j].z * xv[j].z + xv[j].w * xv[j].w);
            const float r = __builtin_amdgcn_rsqf(wave_sum(ss) * (1.f / D) + EPS);
            u32x2* o8 = (u32x2*)(XN + (size_t)m * D) + lane;
#pragma unroll
            for (int j = 0; j < 4; ++j) { const f32x4 g = ((const f32x4*)gpre)[lane + 64 * j]; const f32x4 v = xv[j] * g * r; u32x2 w; w.x = pk2bf(v.x, v.y); w.y = pk2bf(v.z, v.w); o8[64 * j] = w; }
        }
    }
}
__device__ __forceinline__ void p_to_bf16(const float* P, bf16_t* PB, int gw, int NGW, int lane) {
    for (int m = gw; m < M; m += NGW) { const f32x4 v = ((const f32x4*)(P + (size_t)m * PLE))[lane]; u32x2 w; w.x = pk2bf(v.x, v.y); w.y = pk2bf(v.z, v.w); ((u32x2*)(PB + (size_t)m * PLE))[lane] = w; }
}

__device__ __forceinline__ int crow(int r, int hb) { return (r & 3) + 8 * (r >> 2) + 4 * hb; }
__device__ __forceinline__ int swap23(int i) { return (i & ~12) | ((i & 4) << 1) | ((i & 8) >> 1); }
#define MFMA32(a, b, c) __builtin_amdgcn_mfma_f32_32x32x16_bf16((a), (b), (c), 0, 0, 0)

__device__ __forceinline__ void da_unit(const bf16_t* QK, const bf16_t* VT, bf16_t* O, int b, int h, int qb, int c, float lam, float slope2,
                                        const float* subln_g, float outscale, LAS float* xch, LAS unsigned char* stg, int lane) {
    const int r32 = lane & 31, hb = lane >> 5;
    const size_t tok0 = (size_t)b * SEQ;
    const bf16_t* qp = QK + (tok0 + 32 * qb + r32) * 2048 + h * 128 + c * 64 + 8 * hb;
    bf16x8 qf[4];
#pragma unroll
    for (int d0 = 0; d0 < 4; ++d0) qf[d0] = *(const bf16x8*)(qp + 16 * d0);
    f32x16 o[4];
#pragma unroll
    for (int eb = 0; eb < 4; ++eb)
#pragma unroll
        for (int r = 0; r < 16; ++r) o[eb][r] = 0.f;
    float mref = -INFINITY, l = 0.f;
    const int nkb = 2 * ((qb >> 1) + 1);
    const int tq = 32 * qb + r32;
    const bf16_t* kbase = QK + (tok0 + swap23(r32)) * 2048 + 1024 + h * 128 + c * 64 + 8 * hb;
    const bf16_t* vbase = VT + (size_t)(h * 128 + r32) * M + tok0 + 8 * hb;
    constexpr float SC2 = 0.125f * LOG2E;
    for (int kb = nkb - 1; kb >= 0; --kb) {
        const bf16_t* kp = kbase + (size_t)(32 * kb) * 2048;
        bf16x8 kf[4];
#pragma unroll
        for (int d0 = 0; d0 < 4; ++d0) kf[d0] = *(const bf16x8*)(kp + 16 * d0);
        bf16x8 vf[4][2];
#pragma unroll
        for (int eb = 0; eb < 4; ++eb)
#pragma unroll
            for (int ks = 0; ks < 2; ++ks) vf[eb][ks] = *(const bf16x8*)(vbase + (size_t)(32 * eb) * M + 32 * kb + 16 * ks);
        f32x16 s;
#pragma unroll
        for (int r = 0; r < 16; ++r) s[r] = 0.f;
#pragma unroll
        for (int d0 = 0; d0 < 4; ++d0) s = MFMA32(kf[d0], qf[d0], s);
        const int dq = tq - (32 * kb + 8 * hb);
        float bm = -INFINITY;
#pragma unroll
        for (int r = 0; r < 16; ++r) { const int dd = dq - (16 * (r >> 3) + (r & 7)); const float dist = (float)(dd < 0 ? -dd : dd); s[r] = s[r] * SC2 - slope2 * dist; bm = fmaxf(bm, s[r]); }
        bm = fmaxf(bm, __shfl_xor(bm, 32));
        if (__any(bm > mref + 8.0f)) {
            const float mn = fmaxf(mref, bm); const float al = __builtin_amdgcn_exp2f(mref - mn); l *= al;
#pragma unroll
            for (int eb = 0; eb < 4; ++eb)
#pragma unroll
                for (int r = 0; r < 16; ++r) o[eb][r] *= al;
            mref = mn;
        }
        float ps = 0.f;
#pragma unroll
        for (int r = 0; r < 16; ++r) { s[r] = __builtin_amdgcn_exp2f(s[r] - mref); ps += s[r]; }
        l += ps;
        bf16x8 pb[2];
#pragma unroll
        for (int ks = 0; ks < 2; ++ks) { u32x4 w; w.x = pk2bf(s[8 * ks + 0], s[8 * ks + 1]); w.y = pk2bf(s[8 * ks + 2], s[8 * ks + 3]); w.z = pk2bf(s[8 * ks + 4], s[8 * ks + 5]); w.w = pk2bf(s[8 * ks + 6], s[8 * ks + 7]); pb[ks] = __builtin_bit_cast(bf16x8, w); }
#pragma unroll
        for (int eb = 0; eb < 4; ++eb)
#pragma unroll
            for (int ks = 0; ks < 2; ++ks) o[eb] = MFMA32(vf[eb][ks], pb[ks], o[eb]);
    }
    l += __shfl_xor(l, 32);
    const float inv = 1.0f / l;
    if (c == 1) { const float w = -lam * inv;
#pragma unroll
        for (int eb = 0; eb < 4; ++eb)
#pragma unroll
            for (int r = 0; r < 16; ++r) xch[(eb * 16 + r) * 64 + lane] = o[eb][r] * w; }
    __syncthreads();
    if (c == 0) {
        float ss = 0.f;
#pragma unroll
        for (int eb = 0; eb < 4; ++eb)
#pragma unroll
            for (int r = 0; r < 16; ++r) { const float v = o[eb][r] * inv + xch[(eb * 16 + r) * 64 + lane]; o[eb][r] = v; ss += v * v; }
        ss += __shfl_xor(ss, 32);
        const float rn = __builtin_amdgcn_rsqf(ss * (1.f / 128.f) + EPS) * outscale;
#pragma unroll
        for (int eb = 0; eb < 4; ++eb)
#pragma unroll
            for (int r = 0; r < 16; r += 2) { const int e = 32 * eb + crow(r, hb); const float v0 = o[eb][r] * rn * subln_g[e], v1 = o[eb][r + 1] * rn * subln_g[e + 1];
                *(LAS unsigned*)(stg + r32 * 272 + e * 2) = pk2bf(v0, v1); }
        asm volatile("s_waitcnt lgkmcnt(0)" ::: "memory");
#pragma unroll
        for (int i = 0; i < 8; ++i) { const int idx = i * 64 + lane, row = idx >> 4, ch = idx & 15; const u32x4 v = *(const LAS u32x4*)(stg + row * 272 + ch * 16);
            *(u32x4*)(O + (tok0 + 32 * qb + row) * D + h * 128 + ch * 8) = v; }
    }
    __syncthreads();
}

__device__ __forceinline__ void sb_unit(const bf16_t* QK, const bf16_t* VT, bf16_t* O, int b, int h, int qb, LAS unsigned char* stg, int lane) {
    const int r32 = lane & 31, hb = lane >> 5;
    const size_t tok0 = (size_t)b * SEQ;
    const bf16_t* qp = QK + (tok0 + 32 * qb + r32) * 2048 + h * 64 + 8 * hb;
    bf16x8 qf[4];
#pragma unroll
    for (int d0 = 0; d0 < 4; ++d0) qf[d0] = *(const bf16x8*)(qp + 16 * d0);
    f32x16 o[2];
#pragma unroll
    for (int eb = 0; eb < 2; ++eb)
#pragma unroll
        for (int r = 0; r < 16; ++r) o[eb][r] = 0.f;
    float carry = 1.0f;
    const bf16_t* kbase = QK + (tok0 + swap23(r32)) * 2048 + 1024 + h * 64 + 8 * hb;
    const bf16_t* vbase = VT + (size_t)(h * 64 + r32) * M + tok0 + 8 * hb;
    constexpr float SC2 = 0.125f * LOG2E;
    for (int kb = qb; kb >= 0; --kb) {
        const bf16_t* kp = kbase + (size_t)(32 * kb) * 2048;
        bf16x8 kf[4];
#pragma unroll
        for (int d0 = 0; d0 < 4; ++d0) kf[d0] = *(const bf16x8*)(kp + 16 * d0);
        bf16x8 vf[2][2];
#pragma unroll
        for (int eb = 0; eb < 2; ++eb)
#pragma unroll
            for (int ks = 0; ks < 2; ++ks) vf[eb][ks] = *(const bf16x8*)(vbase + (size_t)(32 * eb) * M + 32 * kb + 16 * ks);
        f32x16 s;
#pragma unroll
        for (int r = 0; r < 16; ++r) s[r] = 0.f;
#pragma unroll
        for (int d0 = 0; d0 < 4; ++d0) s = MFMA32(kf[d0], qf[d0], s);
        float om[16];
#pragma unroll
        for (int r = 0; r < 16; ++r) { const float e = __builtin_amdgcn_exp2f(s[r] * SC2); om[r] = __builtin_amdgcn_rcpf(1.0f + e); }
        if (kb == qb) {
            const int dq = r32 - 8 * hb;
#pragma unroll
            for (int r = 0; r < 16; ++r) { if (dq - (16 * (r >> 3) + (r & 7)) <= 0) om[r] = 1.0f; }
        }
        float sufA[8], sufB[8];
        sufA[7] = 1.0f; sufB[7] = 1.0f;
#pragma unroll
        for (int j = 6; j >= 0; --j) { sufA[j] = sufA[j + 1] * om[j + 1]; sufB[j] = sufB[j + 1] * om[8 + j + 1]; }
        const float TA = sufA[0] * om[0], TB = sufB[0] * om[8];
        const float pTA = __shfl_xor(TA, 32), pTB = __shfl_xor(TB, 32);
        const float multB = hb ? carry : carry * pTB;
        const float multA = hb ? carry * TB * pTB : carry * pTB * TB * pTA;
        carry = carry * ((TA * TB) * (pTA * pTB));
        float a[16];
#pragma unroll
        for (int j = 0; j < 8; ++j) { a[j] = (1.0f - om[j]) * sufA[j] * multA; a[8 + j] = (1.0f - om[8 + j]) * sufB[j] * multB; }
        bf16x8 pb[2];
#pragma unroll
        for (int ks = 0; ks < 2; ++ks) { u32x4 w; w.x = pk2bf(a[8 * ks + 0], a[8 * ks + 1]); w.y = pk2bf(a[8 * ks + 2], a[8 * ks + 3]); w.z = pk2bf(a[8 * ks + 4], a[8 * ks + 5]); w.w = pk2bf(a[8 * ks + 6], a[8 * ks + 7]); pb[ks] = __builtin_bit_cast(bf16x8, w); }
#pragma unroll
        for (int eb = 0; eb < 2; ++eb)
#pragma unroll
            for (int ks = 0; ks < 2; ++ks) o[eb] = MFMA32(vf[eb][ks], pb[ks], o[eb]);
    }
#pragma unroll
    for (int eb = 0; eb < 2; ++eb)
#pragma unroll
        for (int r = 0; r < 16; r += 2) { const int e = 32 * eb + crow(r, hb); *(LAS unsigned*)(stg + r32 * 144 + e * 2) = pk2bf(o[eb][r], o[eb][r + 1]); }
    asm volatile("s_waitcnt lgkmcnt(0)" ::: "memory");
#pragma unroll
    for (int i = 0; i < 4; ++i) { const int idx = i * 64 + lane, row = idx >> 3, ch = idx & 7; const u32x4 v = *(const LAS u32x4*)(stg + row * 144 + ch * 16);
        *(u32x4*)(O + (tok0 + 32 * qb + row) * D + h * 64 + ch * 8) = v; }
    asm volatile("s_waitcnt lgkmcnt(0)" ::: "memory");
}

#define XB_TMO      128
#define XB_XCNT(j)  (256  + 64 * (j))
#define XB_XSUB(j)  (1280 + 64 * (j))
#define XB_XGEN(j)  (2304 + 64 * (j))
#define XB_TOP      3328
#define XB_TOPGEN   3392
#define XCD_BAR_WORDS 3456
#define XB_SPIN_CAP (1u << 18)

__device__ __forceinline__ unsigned xb_ld(unsigned* p)              { return __hip_atomic_load(p, __ATOMIC_RELAXED, __HIP_MEMORY_SCOPE_AGENT); }
__device__ __forceinline__ unsigned xb_add(unsigned* p, unsigned v) { return __hip_atomic_fetch_add(p, v, __ATOMIC_RELAXED, __HIP_MEMORY_SCOPE_AGENT); }
__device__ __forceinline__ unsigned xb_xcc_id() { return (unsigned)__builtin_amdgcn_s_getreg((3 << 11) | 20) & 0xFu; }
#define XB_SPIN(cond, bar) do { unsigned _sp = 0; while (cond) { __builtin_amdgcn_s_sleep(1); \
    if ((++_sp & 255u) == 0u) { if (xb_ld(&(bar)[XB_TMO])) break; if (_sp > XB_SPIN_CAP) { atomicAdd(&(bar)[XB_TMO], 1u); break; } } } } while (0)

struct XcdBarrier {
    unsigned* bar; unsigned x;
    volatile LAS unsigned* st;
};

__device__ __forceinline__ XcdBarrier xcd_barrier_post(unsigned* bar, volatile LAS unsigned* st) {
    XcdBarrier b; b.bar = bar; b.x = xb_xcc_id(); b.st = st;
    if (threadIdx.x == 0) (void)xb_add(&bar[XB_XCNT(b.x)], 1u);
    return b;
}
__device__ __forceinline__ void xcd_barrier_complete(unsigned* bar, unsigned x, unsigned& nloc, unsigned& nx) {
    const unsigned G = gridDim.x * gridDim.y * gridDim.z;
    unsigned sum, cnt, mine, sp = 0u;
    for (;;) {
        sum = 0u; cnt = 0u; mine = 0u;
#pragma unroll
        for (unsigned j = 0; j < 16; ++j) { const unsigned c = xb_ld(&bar[XB_XCNT(j)]); sum += c; cnt += (c > 0u) ? 1u : 0u; mine = (j == x) ? c : mine; }
        if (sum == G) break;
        __builtin_amdgcn_s_sleep(1);
        if ((++sp & 255u) == 0u) { if (xb_ld(&bar[XB_TMO])) break; if (sp > XB_SPIN_CAP) { atomicAdd(&bar[XB_TMO], 1u); break; } }
    }
    nloc = mine > 0u ? mine : 1u; nx = cnt > 0u ? cnt : 1u;
}

__device__ __forceinline__ void xcd_barrier(const XcdBarrier& b) {
    asm volatile("s_waitcnt vmcnt(0)" ::: "memory");
    __syncthreads();
    if (threadIdx.x == 0) {
        unsigned* bar = b.bar;
        __builtin_amdgcn_s_waitcnt(0);
        unsigned nloc = b.st[0], nx = b.st[1];
        if (nloc == 0u) { xcd_barrier_complete(bar, b.x, nloc, nx); b.st[0] = nloc; b.st[1] = nx; }
        const unsigned old = xb_add(&bar[XB_XSUB(b.x)], 1u);
        const unsigned gen = old / nloc;
        if (old + 1u == (gen + 1u) * nloc) {
            __builtin_amdgcn_fence(__ATOMIC_RELEASE, "agent");
            asm volatile("s_waitcnt vmcnt(0)" ::: "memory");
            const unsigned og = xb_add(&bar[XB_TOP], 1u);
            const unsigned tg = og / nx;
            if (og + 1u == (tg + 1u) * nx) xb_add(&bar[XB_TOPGEN], 1u);
            else XB_SPIN(xb_ld(&bar[XB_TOPGEN]) == tg, bar);
            __builtin_amdgcn_fence(__ATOMIC_ACQUIRE, "agent");
            xb_add(&bar[XB_XGEN(b.x)], 1u);
            asm volatile("s_waitcnt vmcnt(0)" ::: "memory");
        } else {
            XB_SPIN(xb_ld(&bar[XB_XGEN(b.x)]) == gen, bar);
            __builtin_amdgcn_fence(__ATOMIC_ACQUIRE, "agent");
            asm volatile("s_waitcnt vmcnt(0)" ::: "memory");
        }
    }
    __syncthreads();
}

struct Args { const float* in[15]; float* out; unsigned char* ws; };
static_assert(sizeof(Args) == 15 * 8 + 8 + 8, "Args has no padding");
struct KA {
    const unsigned char* p;
    __device__ __forceinline__ KA() { p = (const unsigned char*)__builtin_amdgcn_kernarg_segment_ptr(); asm volatile("" : "+s"(p)); }
    __device__ __forceinline__ const float* in(int i) const { return *(const float* const*)(p + 8 * i); }
    __device__ __forceinline__ float* out() const { return *(float* const*)(p + 120); }
    __device__ __forceinline__ unsigned char* ws() const { return *(unsigned char* const*)(p + 128); }
};
struct WaveId { int lane, wave, gw, NGW, G, bx; };
__device__ __forceinline__ WaveId wave_id() { int t = threadIdx.x; asm volatile("" : "+v"(t)); WaveId w; w.lane = t & 63; w.wave = __builtin_amdgcn_readfirstlane(t >> 6); w.G = gridDim.x; w.bx = blockIdx.x; w.gw = w.bx * NWAVES + w.wave; w.NGW = w.G * NWAVES; return w; }
__device__ __forceinline__ void layer_weights(const KA& ka, int i, LayerW& L) { L.w1in = ka.in(3) + (size_t)i * D * 2 * FF; L.w1out = ka.in(4) + (size_t)i * FF * D; L.w2in = ka.in(5) + (size_t)i * D * 2 * FF; L.w2out = ka.in(6) + (size_t)i * FF * D;
    L.wqkv = (i == 0) ? ka.in(7) : ka.in(11); L.wo = (i == 0) ? ka.in(8) : ka.in(12); L.wproj = ka.in(13) + (size_t)i * PLE * D; L.wgate = ka.in(14) + (size_t)i * D * D; }

constexpr int MISC_OFF = 131072 + 64;
constexpr size_t WS_BAR = 16384;
#define SEAM() do { KA ka_; XcdBarrier b_; b_.bar = (unsigned*)(ka_.ws() + WS_BAR); b_.x = xb_xcc_id(); b_.st = (volatile LAS unsigned*)(lds + MISC_OFF); xcd_barrier(b_); } while (0)
#ifndef PMASK
#define PMASK 0xffff
#endif
#define EN(k) ((PMASK >> (k)) & 1)
template <class Epi> __device__ __forceinline__ void run_gemm(LAS unsigned char* lds, const bf16_t* A, const bf16_t* Bt, int Mr, int Nr, int Kr, const Epi& E) {
    pg8::Gemm gm{A, Bt, Mr, Nr, Kr}; pg8::StaticOrder S; S.init(Mr, Nr, (int)gridDim.x, (int)blockIdx.x);
    pg8::gemm_phase<Epi, pg8::StaticOrder, PG8_ALIGN, PG8_SP2>(lds, gm, S, E);
}

template <int LAYER> __device__ __forceinline__ void layer_body(LAS unsigned char* lds, cg::grid_group& grid) {
    if (EN(0)) { KA ka; unsigned char* ws = ka.ws(); EpiSwiglu E{(bf16_t*)(ws + WS_H)}; run_gemm(lds, (const bf16_t*)(ws + WS_XN), (const bf16_t*)(ws + WS_W1IN), M, 2 * FF, D, E); }
    SEAM();
    if (EN(1)) { KA ka; unsigned char* ws = ka.ws(); EpiF32 E{(float*)(ws + WS_Y), D}; run_gemm(lds, (const bf16_t*)(ws + WS_H), (const bf16_t*)(ws + WS_W1OUT), M, D, FF, E); }
    SEAM();
    if (EN(2)) { KA ka; unsigned char* ws = ka.ws(); const WaveId w = wave_id(); const float* g = ka.in(2) + (size_t)LAYER * 8 * D; float* xres = ka.out();
        rows_phase((const float*)(ws + WS_Y), 0.5f, g + 1 * D, g + 2 * D, xres, xres, (bf16_t*)(ws + WS_XN), w.gw, w.NGW, w.lane); }
    SEAM();
    if (EN(3)) {
        { KA ka; unsigned char* ws = ka.ws(); EpiBf E{(bf16_t*)(ws + WS_QK), 2 * D}; run_gemm(lds, (const bf16_t*)(ws + WS_XN), (const bf16_t*)(ws + WS_WQKV), M, 2 * D, D, E); }
        { KA ka; unsigned char* ws = ka.ws(); EpiBf E{(bf16_t*)(ws + WS_VT), M}; run_gemm(lds, (const bf16_t*)(ws + WS_WQKV) + (size_t)2 * D * D, (const bf16_t*)(ws + WS_XN), D, M, D, E); }
    }
    SEAM();
    if (EN(4)) {
        KA ka; unsigned char* ws = ka.ws(); const WaveId w = wave_id();
        const bf16_t* QK = (const bf16_t*)(ws + WS_QK); const bf16_t* VT = (const bf16_t*)(ws + WS_VT); bf16_t* O = (bf16_t*)(ws + WS_XN);
#ifndef NO_DA
        if (LAYER == 0) {
            const float* lv = ka.in(9); const float* subln = ka.in(10);
            const float lambda_init = 0.8f - 0.6f * 1.0f;
            const float s1 = wave_sum(lv[w.lane] * lv[64 + w.lane]), s2 = wave_sum(lv[128 + w.lane] * lv[192 + w.lane]);
            const float lam = __expf(s1) - __expf(s2) + lambda_init;
            const int wp = w.bx * 4 + (w.wave >> 1), c = w.wave & 1;
            const int bh = wp >> 4, j0 = (wp & 15) * 2;
            const int b = bh >> 3, h = bh & 7;
            const float slope2 = exp2f(-(float)(h + 1)) * LOG2E;
            LAS float* xch = (LAS float*)(lds + (w.wave >> 1) * 32768);
            LAS unsigned char* stg = lds + (w.wave >> 1) * 32768 + 16384;
#pragma unroll 1
            for (int u = 0; u < 4; ++u) { const int j = j0 + (u >> 1); const int qb = (u & 1) ? 63 - j : j;
                da_unit(QK, VT, O, b, h, qb, c, lam, slope2, subln, 1.0f - lambda_init, xch, stg, w.lane); }
        }
#endif
#ifndef NO_SB
        if (LAYER == 1) {
            const int bh = w.gw >> 4, j0 = (w.gw & 15) * 2;
            const int b = bh >> 4, h = bh & 15;
            LAS unsigned char* stg = lds + w.wave * 8192;
#pragma unroll 1
            for (int u = 0; u < 4; ++u) { const int j = j0 + (u >> 1); const int qb = (u & 1) ? 63 - j : j;
                sb_unit(QK, VT, O, b, h, qb, stg, w.lane); }
        }
#endif
    }
    SEAM();
    if (EN(5)) { KA ka; unsigned char* ws = ka.ws(); EpiF32 E{(float*)(ws + WS_Y), D}; run_gemm(lds, (const bf16_t*)(ws + WS_XN), (const bf16_t*)(ws + WS_WO), M, D, D, E); }
    SEAM();
    if (EN(6)) { KA ka; unsigned char* ws = ka.ws(); const WaveId w = wave_id(); const float* g = ka.in(2) + (size_t)LAYER * 8 * D; float* xres = ka.out();
        rows_phase((const float*)(ws + WS_Y), 1.0f, g + 3 * D, g + 4 * D, xres, xres, (bf16_t*)(ws + WS_XN), w.gw, w.NGW, w.lane);
        p_to_bf16(ka.in(1) + (size_t)LAYER * M * PLE, (bf16_t*)(ws + WS_PB), w.gw, w.NGW, w.lane); }
    SEAM();
    if (EN(7)) { KA ka; unsigned char* ws = ka.ws(); EpiSwiglu E{(bf16_t*)(ws + WS_H)}; run_gemm(lds, (const bf16_t*)(ws + WS_XN), (const bf16_t*)(ws + WS_W2IN), M, 2 * FF, D, E); }
    SEAM();
    if (EN(8)) { KA ka; unsigned char* ws = ka.ws(); EpiF32 E{(float*)(ws + WS_Y), D}; run_gemm(lds, (const bf16_t*)(ws + WS_H), (const bf16_t*)(ws + WS_W2OUT), M, D, FF, E); }
    SEAM();
    if (EN(9)) {
        { KA ka; unsigned char* ws = ka.ws(); const WaveId w = wave_id(); const float* g = ka.in(2) + (size_t)LAYER * 8 * D; float* xres = ka.out();
          rows_phase((const float*)(ws + WS_Y), 0.5f, g + 5 * D, g + 6 * D, xres, xres, (bf16_t*)(ws + WS_XN), w.gw, w.NGW, w.lane); }
        { KA ka; unsigned char* ws = ka.ws(); EpiBf E{(bf16_t*)(ws + WS_E), D}; run_gemm(lds, (const bf16_t*)(ws + WS_PB), (const bf16_t*)(ws + WS_WPROJ), M, D, PLE, E); }
    }
    SEAM();
    if (EN(10)) { KA ka; unsigned char* ws = ka.ws(); EpiGate E{(float*)(ws + WS_Y), (const bf16_t*)(ws + WS_E)}; run_gemm(lds, (const bf16_t*)(ws + WS_XN), (const bf16_t*)(ws + WS_WGATE), M, D, D, E); }
    SEAM();
    if (EN(11)) {
        { KA ka; unsigned char* ws = ka.ws(); const WaveId w = wave_id(); const float* g = ka.in(2) + (size_t)LAYER * 8 * D; float* xres = ka.out();
          rows_phase((const float*)(ws + WS_Y), 1.0f, g + 7 * D, (LAYER + 1 < DEPTH) ? g + 8 * D : nullptr, xres, xres, (bf16_t*)(ws + WS_XN), w.gw, w.NGW, w.lane); }
        if (LAYER + 1 < DEPTH) { KA ka; const WaveId w = wave_id(); LayerW L; layer_weights(ka, LAYER + 1, L); convert_weights(L, ka.ws(), (LAS float*)(lds + w.wave * 16384), w.gw, w.NGW, w.lane); }
    }
}

__global__ void __launch_bounds__(NWAVES * 64, 2) fwd_megakernel(Args args) {
    extern __shared__ __attribute__((aligned(16))) unsigned char lds_raw[];
    LAS unsigned char* lds = (LAS unsigned char*)lds_raw;
    cg::grid_group grid = cg::this_grid();
    if (threadIdx.x < 64) ((LAS unsigned*)(lds + 131072))[threadIdx.x] = 0u;
    __syncthreads();
    { KA ka; (void)xcd_barrier_post((unsigned*)(ka.ws() + WS_BAR), (volatile LAS unsigned*)(lds + MISC_OFF)); }
    {
        { KA ka; const WaveId w = wave_id(); LayerW L; layer_weights(ka, 0, L); convert_weights(L, ka.ws(), (LAS float*)(lds + w.wave * 16384), w.gw, w.NGW, w.lane); }
        { KA ka; const WaveId w = wave_id(); rows_phase(nullptr, 0.f, nullptr, ka.in(2), ka.in(0), ka.out(), (bf16_t*)(ka.ws() + WS_XN), w.gw, w.NGW, w.lane); }
    }
    grid.sync();
    layer_body<0>(lds, grid);
    SEAM();
    layer_body<1>(lds, grid);
}

extern "C" void kernel_launch(void* const* d_in, const int* in_sizes, int n_in, void* d_out, int out_size, void* d_ws, size_t ws_size, hipStream_t stream) {
    static int grid = 0;
    if (grid == 0) {
        if (n_in != 15 || in_sizes[0] != M * D || out_size != M * D || ws_size < WS_END) { fprintf(stderr, "kernel_launch: unexpected shapes (n_in %d, in0 %d, out %d, ws %zu)\n", n_in, n_in > 0 ? in_sizes[0] : -1, out_size, ws_size); grid = -1; return; }
        int dev = 0, cus = 0, per_cu = 0;
        if (hipGetDevice(&dev) != hipSuccess || hipDeviceGetAttribute(&cus, hipDeviceAttributeMultiprocessorCount, dev) != hipSuccess) { grid = -1; return; }
        if (hipFuncSetAttribute((const void*)fwd_megakernel, hipFuncAttributeMaxDynamicSharedMemorySize, LDS_BYTES) != hipSuccess) { fprintf(stderr, "kernel_launch: hipFuncSetAttribute failed\n"); grid = -1; return; }
        if (hipOccupancyMaxActiveBlocksPerMultiprocessor(&per_cu, (const void*)fwd_megakernel, NWAVES * 64, LDS_BYTES) != hipSuccess || per_cu < 1) { fprintf(stderr, "kernel_launch: occupancy query says %d\n", per_cu); per_cu = 1; }
        (void)hipGetLastError();
        grid = cus;
    }
    if (grid < 0) return;
    if (hipMemsetAsync(d_ws, 0, 1u << 20, stream) != hipSuccess) { fprintf(stderr, "kernel_launch: memset failed\n"); return; }
    Args a{};
    for (int i = 0; i < 15; ++i) a.in[i] = (const float*)d_in[i];
    a.out = (float*)d_out; a.ws = (unsigned char*)d_ws;
    void* kargs[] = {&a};
    hipError_t e = hipLaunchCooperativeKernel((const void*)fwd_megakernel, dim3(grid), dim3(NWAVES * 64), kargs, LDS_BYTES, stream);
    if (e != hipSuccess) fprintf(stderr, "kernel_launch: cooperative launch failed: %s (grid %d)\n", hipGetErrorString(e), grid);
}
```

```cpp
#include <hip/hip_runtime.h>
#include <cstdio>
#include <cstdint>
namespace pg8 {
#define PG8_LAS __attribute__((address_space(3)))
typedef unsigned short bf16_t;
typedef short bf16x8 __attribute__((ext_vector_type(8)));
typedef float f32x4 __attribute__((ext_vector_type(4)));
typedef unsigned u32x4 __attribute__((ext_vector_type(4)));
constexpr int BM = 256, BK = 64, HALF = 128, HTB = HALF * BK * 2  , STAGE_BYTES = 8 * HTB, NXCD = 8, WGM = 8;

__host__ __device__ __forceinline__ int lds_byte(int r, int c) { const int st = (r >> 4) * 2 + (c >> 5), rr = r & 15, cc = c & 31, ob = rr * 64 + cc * 2; return st * 1024 + (ob ^ (((ob >> 9) & 1) << 5)); }
__host__ __device__ __forceinline__ void stage_rc(int b, int& R, int& C) { const int st = b / 1024, sb = b % 1024, swz = sb ^ (((sb >> 9) & 1) << 5); R = (st >> 1) * 16 + swz / 64; C = (st & 1) * 32 + (swz % 64) / 2; }
__host__ __device__ __forceinline__ int perm32(int rho) { const int n = rho >> 4, i = rho & 15; return 8 * (i >> 2) + 4 * n + (i & 3); }

struct Unit { int pm, pn; };
struct Gemm { const bf16_t* A; const bf16_t* Bt; int M, N, K; };

struct StaticOrder {
    int nM, nN, nwg, G, c;
    __host__ __device__ void init(int M, int N, int G_, int c_) { nM = M / BM; nN = N / BM; nwg = nM * nN; G = G_; c = c_; }
    __host__ __device__ bool next(int i, Unit& u) const {
        const long L = (long)i * G + c; if (L >= nwg) return false;
        int wgid = (int)L; { const int q = nwg / NXCD, r = nwg % NXCD, xcd = wgid % NXCD, off = wgid / NXCD; wgid = (xcd < r ? xcd * (q + 1) : r * (q + 1) + (xcd - r) * q) + off; }
        const int nig = WGM * nN, gid = wgid / nig, fm = gid * WGM, gsz = (nM - fm) < WGM ? (nM - fm) : WGM;
        u.pm = fm + ((wgid % nig) % gsz); u.pn = (wgid % nig) / gsz; return true;
    }
    __device__ __forceinline__ void a_ready(const Unit&) const {}
    __device__ __forceinline__ void done(const Unit&) const {}
};

__device__ __forceinline__ unsigned cvt_pk_bf16(float lo, float hi) { unsigned r; asm volatile("v_cvt_pk_bf16_f32 %0, %1, %2" : "=v"(r) : "v"(lo), "v"(hi)); return r; }
typedef float f32x2 __attribute__((ext_vector_type(2)));
__device__ __forceinline__ f32x2 gelu_pk(f32x2 v) {
    const f32x2 av = __builtin_elementwise_abs(v), d = av * 0.2316418882f + 1.0f;
    f32x2 t; t.x = __builtin_amdgcn_rcpf(d.x); t.y = __builtin_amdgcn_rcpf(d.y);
    f32x2 q = t * 0.5307027145f + (-0.7265760135f); q = q * t + 0.7107068705f; q = q * t + (-0.142248368f); q = q * t + 0.127414796f; q = q * t;
    const f32x2 s = (v * v) * (-0.72134752044f);
    f32x2 e; e.x = __builtin_amdgcn_exp2f(s.x); e.y = __builtin_amdgcn_exp2f(s.y);
    const f32x2 m = v * (q * e), r = v - m;
    f32x2 o; o.x = v.x < 0.f ? m.x : r.x; o.y = v.y < 0.f ? m.y : r.y; return o;
}

template <int ACT  > struct EpiBf16 {
    static constexpr bool PERM = true, AFTER_DRAIN = false; static_assert(ACT == 0 || ACT == 1, "EpiBf16: ACT is 0 (none) or 1 (gelu_pk)");
    bf16_t* O; int ldc; const float* bias; int split_cols; size_t split_stride; float scale0;
    __device__ __forceinline__ void operator()(const f32x4 (&acc)[2][2][4][2], const Unit& u, int wr, int wc, int fr, int fq) const {
        const int row0 = u.pm * BM + wr * 64 + fr; int colt = u.pn * BM; bf16_t* base = O;
        float sc = 1.f; if (split_cols) { const int t = colt / split_cols; base += (size_t)t * split_stride; colt -= t * split_cols; if (t == 0) sc = scale0; }
        const int col0 = colt + wc * 32 + 8 * fq, bcol0 = u.pn * BM + wc * 32 + 8 * fq;
        f32x4 bv[2][2];
#pragma unroll
        for (int bj = 0; bj < 2; ++bj)
#pragma unroll
            for (int n = 0; n < 2; ++n) bv[bj][n] = bias ? *(const f32x4*)(bias + bcol0 + bj * HALF + 4 * n) : (f32x4){0.f, 0.f, 0.f, 0.f};
#pragma unroll
        for (int ai = 0; ai < 2; ++ai)
#pragma unroll
            for (int m = 0; m < 4; ++m) { bf16_t* rowp = base + (size_t)(row0 + ai * HALF + m * 16) * ldc + col0;
#pragma unroll
                for (int bj = 0; bj < 2; ++bj) { f32x4 v0 = acc[ai][bj][m][0] + bv[bj][0], v1 = acc[ai][bj][m][1] + bv[bj][1];
                    if (ACT == 1) { f32x2 a = gelu_pk((f32x2){v0[0], v0[1]}), b = gelu_pk((f32x2){v0[2], v0[3]}), c = gelu_pk((f32x2){v1[0], v1[1]}), d = gelu_pk((f32x2){v1[2], v1[3]});
                        v0 = (f32x4){a.x, a.y, b.x, b.y}; v1 = (f32x4){c.x, c.y, d.x, d.y}; }
                    v0 = v0 * sc; v1 = v1 * sc; u32x4 w; w.x = cvt_pk_bf16(v0[0], v0[1]); w.y = cvt_pk_bf16(v0[2], v0[3]); w.z = cvt_pk_bf16(v1[0], v1[1]); w.w = cvt_pk_bf16(v1[2], v1[3]);
                    *(u32x4*)(rowp + bj * HALF) = w; } }
    }
};

struct PanelStats {
    unsigned* xbuf;
    unsigned* cnt;
    unsigned* tmo;
    int ntn; float eps;
    unsigned code;
    __device__ __forceinline__ bool run(const f32x4 (&v)[2][2][4][2], const Unit& u, int wr, int wc, int fr, int fq, PG8_LAS unsigned char* lds, int wid, int lane) const {
        typedef float f32x2v __attribute__((ext_vector_type(2)));
        PG8_LAS f32x2v* P = (PG8_LAS f32x2v*)lds;
        PG8_LAS f32x2v* S = (PG8_LAS f32x2v*)(lds + 8192);
        PG8_LAS unsigned* flag = (PG8_LAS unsigned*)(lds + 8192 + 2048);
#pragma unroll
        for (int ai = 0; ai < 2; ++ai)
#pragma unroll
            for (int m = 0; m < 4; ++m) {
                float s = 0.f;
#pragma unroll
                for (int bj = 0; bj < 2; ++bj)
#pragma unroll
                    for (int n = 0; n < 2; ++n) { const f32x4 x = v[ai][bj][m][n]; s += (x[0] + x[1]) + (x[2] + x[3]); }
                s += __shfl_xor(s, 16); s += __shfl_xor(s, 32);
                const float mw = s * (1.0f / 64.0f); float q = 0.f;
#pragma unroll
                for (int bj = 0; bj < 2; ++bj)
#pragma unroll
                    for (int n = 0; n < 2; ++n) { const f32x4 d = v[ai][bj][m][n] - mw; q += (d[0] * d[0] + d[1] * d[1]) + (d[2] * d[2] + d[3] * d[3]); }
                q += __shfl_xor(q, 16); q += __shfl_xor(q, 32);
                if (fq == 0) P[(ai * HALF + wr * 64 + m * 16 + fr) * 4 + wc] = (f32x2v){mw, q};
            }
        asm volatile("s_waitcnt lgkmcnt(0)" ::: "memory"); __builtin_amdgcn_s_barrier(); asm volatile("" ::: "memory");
#if defined(BROKEN_EXCHANGE_NO_WAIT)
#warning BROKEN CONTROL BUILD: the row-statistics exchange does not wait; results are wrong by design
        if (blockIdx.x >= 64) { const long long t0_ = clock64(); while (clock64() - t0_ < 60000) __builtin_amdgcn_s_sleep(8); }
#endif
        const int row = wid * 32 + (lane & 31);
        if (lane < 32) {
            const f32x2v a = P[row * 4 + 0], b = P[row * 4 + 1], c = P[row * 4 + 2], d = P[row * 4 + 3];
            const float mt = (a.x + b.x + c.x + d.x) * 0.25f;
            const float da = a.x - mt, db = b.x - mt, dc = c.x - mt, dd = d.x - mt;
            const float m2 = (a.y + b.y) + (c.y + d.y) + 64.0f * ((da * da + db * db) + (dc * dc + dd * dd));
            unsigned long long* slot = (unsigned long long*)xbuf + ((size_t)(u.pm * BM + row) * 4 + u.pn);
            __hip_atomic_store(slot, ((unsigned long long)__float_as_uint(m2) << 32) | __float_as_uint(mt), __ATOMIC_RELAXED, __HIP_MEMORY_SCOPE_AGENT);
        }
        asm volatile("s_waitcnt vmcnt(0)" ::: "memory");
        if (lane == 0) __hip_atomic_fetch_add(cnt + 64 * u.pm, 1u, __ATOMIC_RELAXED, __HIP_MEMORY_SCOPE_AGENT);
        if (wid == 0) {
            bool dead = false; const unsigned long long t0 = __builtin_amdgcn_s_memrealtime(); const unsigned want = 8u * (unsigned)ntn;
            for (;;) {
#if defined(BROKEN_EXCHANGE_NO_WAIT)
                break;
#endif
                if ((unsigned)__builtin_amdgcn_readfirstlane(__hip_atomic_load(cnt + 64 * u.pm, __ATOMIC_RELAXED, __HIP_MEMORY_SCOPE_AGENT)) >= want) break;
                if (__builtin_amdgcn_s_memrealtime() - t0 > 2000000ull) {
                    if (lane == 0) { unsigned expect = 0u; __hip_atomic_compare_exchange_strong(tmo + 1, &expect, code | (unsigned)(u.pm & 0xff), __ATOMIC_RELAXED, __ATOMIC_RELAXED, __HIP_MEMORY_SCOPE_AGENT);
                                     __hip_atomic_store(tmo, 1u, __ATOMIC_RELAXED, __HIP_MEMORY_SCOPE_AGENT); }
                    dead = true; break; }
                __builtin_amdgcn_s_sleep(2);
            }
            __builtin_amdgcn_fence(__ATOMIC_ACQUIRE, "agent");
            if (lane == 0) flag[0] = dead ? 1u : 0u;
        }
        asm volatile("s_waitcnt vmcnt(0) lgkmcnt(0)" ::: "memory"); __builtin_amdgcn_s_barrier(); asm volatile("" ::: "memory");
        const bool bad = flag[0] != 0u;
        if (lane < 32) {
            const unsigned long long* slot = (const unsigned long long*)xbuf + (size_t)(u.pm * BM + row) * 4; float mt[4], m2[4]; float ms = 0.f;
#pragma unroll
            for (int t = 0; t < 4; ++t) { if (t < ntn) { const unsigned long long w = __hip_atomic_load(slot + t, __ATOMIC_RELAXED, __HIP_MEMORY_SCOPE_AGENT); mt[t] = __uint_as_float((unsigned)w); m2[t] = __uint_as_float((unsigned)(w >> 32)); } else { mt[t] = 0.f; m2[t] = 0.f; } ms += mt[t]; }
            const float mean = ms / (float)ntn; float q = 0.f;
#pragma unroll
            for (int t = 0; t < 4; ++t) if (t < ntn) { const float dm = mt[t] - mean; q += m2[t] + 256.0f * dm * dm; }
            S[row] = (f32x2v){mean, 1.0f / sqrtf(q / (256.0f * (float)ntn) + eps)};
        }
        asm volatile("s_waitcnt lgkmcnt(0)" ::: "memory"); __builtin_amdgcn_s_barrier(); asm volatile("" ::: "memory");
        return bad;
    }
};
struct EpiLnRes {
    static constexpr bool PERM = false, AFTER_DRAIN = true;
    const float* base; float* out; int ldc; const float* bias; PanelStats st; unsigned poison;
    __device__ __forceinline__ void fused(f32x4 (&acc)[2][2][4][2], const Unit& u, int wr, int wc, int fr, int fq, PG8_LAS unsigned char* lds, int wid, int lane) const {
        typedef float f32x2v __attribute__((ext_vector_type(2)));
        const PG8_LAS f32x2v* S = (const PG8_LAS f32x2v*)(lds + 8192);
        const int col0 = u.pn * BM + wc * 32 + 4 * fq;
#pragma unroll
        for (int bj = 0; bj < 2; ++bj)
#pragma unroll
            for (int n = 0; n < 2; ++n) { const f32x4 bv = bias ? *(const f32x4*)(bias + col0 + bj * HALF + n * 16) : (f32x4){0.f, 0.f, 0.f, 0.f};
#pragma unroll
                for (int ai = 0; ai < 2; ++ai)
#pragma unroll
                    for (int m = 0; m < 4; ++m) acc[ai][bj][m][n] += bv; }
        f32x4 pre[4][2][2];
#pragma unroll
        for (int m = 0; m < 4; ++m) { const size_t off = (size_t)(u.pm * BM + wr * 64 + m * 16 + fr) * ldc + col0;
#pragma unroll
            for (int bj = 0; bj < 2; ++bj)
#pragma unroll
                for (int n = 0; n < 2; ++n) pre[m][bj][n] = *(const f32x4*)(base + off + bj * HALF + n * 16); }
        const bool bad = st.run(acc, u, wr, wc, fr, fq, lds, wid, lane) || poison != 0u;
        const float qnan = __builtin_nanf("");
#pragma unroll
        for (int ai = 0; ai < 2; ++ai)
#pragma unroll
            for (int m = 0; m < 4; ++m) { const int r = ai * HALF + wr * 64 + m * 16 + fr; const f32x2v sr = S[r]; const size_t off = (size_t)(u.pm * BM + r) * ldc + col0;
#pragma unroll
                for (int bj = 0; bj < 2; ++bj)
#pragma unroll
                    for (int n = 0; n < 2; ++n) { const f32x4 bs = ai == 0 ? pre[m][bj][n] : *(const f32x4*)(base + off + bj * HALF + n * 16); f32x4 o = bs + (acc[ai][bj][m][n] - sr.x) * sr.y;
                        if (bad) o = (f32x4){qnan, qnan, qnan, qnan}; *(f32x4*)(out + off + bj * HALF + n * 16) = o; }
                if (m & 1) asm volatile("" ::: "memory"); }
    }
};
struct EpiLnResLn {
    static constexpr bool PERM = false, AFTER_DRAIN = true;
    const float* base; float* out; bf16_t* xn; int ldc; const float* bias; PanelStats st1, st2; unsigned poison;
    __device__ __forceinline__ void fused(f32x4 (&acc)[2][2][4][2], const Unit& u, int wr, int wc, int fr, int fq, PG8_LAS unsigned char* lds, int wid, int lane) const {
        typedef float f32x2v __attribute__((ext_vector_type(2))); typedef unsigned u32x2v __attribute__((ext_vector_type(2)));
        const PG8_LAS f32x2v* S = (const PG8_LAS f32x2v*)(lds + 8192);
        const int col0 = u.pn * BM + wc * 32 + 4 * fq;
#pragma unroll
        for (int bj = 0; bj < 2; ++bj)
#pragma unroll
            for (int n = 0; n < 2; ++n) { const f32x4 bv = bias ? *(const f32x4*)(bias + col0 + bj * HALF + n * 16) : (f32x4){0.f, 0.f, 0.f, 0.f};
#pragma unroll
                for (int ai = 0; ai < 2; ++ai)
#pragma unroll
                    for (int m = 0; m < 4; ++m) acc[ai][bj][m][n] += bv; }
        bool bad = st1.run(acc, u, wr, wc, fr, fq, lds, wid, lane) || poison != 0u;
        const float qnan = __builtin_nanf("");
#pragma unroll
        for (int ai = 0; ai < 2; ++ai)
#pragma unroll
            for (int m = 0; m < 4; ++m) { const int r = ai * HALF + wr * 64 + m * 16 + fr; const f32x2v sr = S[r]; const size_t off = (size_t)(u.pm * BM + r) * ldc + col0;
#pragma unroll
                for (int bj = 0; bj < 2; ++bj)
#pragma unroll
                    for (int n = 0; n < 2; ++n) { const f32x4 bs = *(const f32x4*)(base + off + bj * HALF + n * 16); acc[ai][bj][m][n] = bs + (acc[ai][bj][m][n] - sr.x) * sr.y; }
                asm volatile("" : "+v"(acc[ai][0][m][0]), "+v"(acc[ai][0][m][1]), "+v"(acc[ai][1][m][0]), "+v"(acc[ai][1][m][1]));
                if (m & 1) asm volatile("" ::: "memory"); }
        const bool bad1 = bad;
        bad = st2.run(acc, u, wr, wc, fr, fq, lds, wid, lane) || bad;
#pragma unroll
        for (int ai = 0; ai < 2; ++ai)
#pragma unroll
            for (int m = 0; m < 4; ++m) { const int r = ai * HALF + wr * 64 + m * 16 + fr; const f32x2v sr = S[r]; const size_t off = (size_t)(u.pm * BM + r) * ldc + col0;
#pragma unroll
                for (int bj = 0; bj < 2; ++bj)
#pragma unroll
                    for (int n = 0; n < 2; ++n) { const f32x4 x1 = acc[ai][bj][m][n]; *(f32x4*)(out + off + bj * HALF + n * 16) = bad1 ? (f32x4){qnan, qnan, qnan, qnan} : x1;
                        const f32x4 o = (x1 - sr.x) * sr.y; u32x2v w; w.x = cvt_pk_bf16(o[0], o[1]); w.y = cvt_pk_bf16(o[2], o[3]);
                        if (bad) { w.x = 0x7fc07fc0u; w.y = 0x7fc07fc0u; } *(u32x2v*)(xn + off + bj * HALF + n * 16) = w; }
                asm volatile("" ::: "memory"); }
    }
};

template <class Epi, class Sched, bool ALIGN_EPI = false, bool SP2 = false>
__device__ __forceinline__ void gemm_phase(PG8_LAS unsigned char* lds, const Gemm g, const Sched& S, const Epi& E) {
    int tid_ = threadIdx.x; asm volatile("" : "+v"(tid_));
    const int tid = tid_, wid = __builtin_amdgcn_readfirstlane(tid >> 6), lane = tid & 63, wr = wid >> 2, wc = wid & 3, fr = lane & 15, fq = lane >> 4;
    const int K = g.K, nt = K / BK;
    unsigned voffA[2], voffB[2];
#pragma unroll
    for (int i = 0; i < 2; ++i) { int R, C; stage_rc(tid * 16 + i * 8192, R, C); const int Rb = Epi::PERM ? ((R & ~31) + perm32(R & 31)) : R;
        voffA[i] = (unsigned)(R * K + C) * 2u; voffB[i] = (unsigned)(Rb * K + C) * 2u; }
    const size_t kstep = (size_t)(BK * 2);
    const size_t hstep = (size_t)HALF * K * 2;
    const size_t tstep = 2 * hstep;
    const unsigned ldsw = (unsigned)wid * 1024u;
    const int aoff = lds_byte(wr * 64 + fr, fq * 8), boff = lds_byte(wc * 32 + fr, fq * 8);
#define PG8_SA(b, h) (((b) * 2 + (h)) * HTB)
#define PG8_SB(b, h) ((4 + (b) * 2 + (h)) * HTB)
#define PG8_STAGE(bufoff, gbase, voff) do { _Pragma("unroll") for (int _i = 0; _i < 2; ++_i) \
        __builtin_amdgcn_global_load_lds((const unsigned*)((const char*)(gbase) + (voff)[_i]), (PG8_LAS unsigned*)(lds + (bufoff) + ldsw + _i * 8192), 16, 0, 0); } while (0)
#define PG8_LDA(dst, b, h) do { _Pragma("unroll") for (int m = 0; m < 4; ++m) _Pragma("unroll") for (int k = 0; k < 2; ++k) dst[m][k] = *(const PG8_LAS bf16x8*)(lds + PG8_SA(b, h) + aoff + m * 2048 + k * 1024); } while (0)
#define PG8_LDB(dst, b, h) do { _Pragma("unroll") for (int n = 0; n < 2; ++n) _Pragma("unroll") for (int k = 0; k < 2; ++k) dst[n][k] = *(const PG8_LAS bf16x8*)(lds + PG8_SB(b, h) + boff + n * 2048 + k * 1024); } while (0)
#define PG8_MMA(ai, bj, At, Bt) do { __builtin_amdgcn_s_setprio(1); _Pragma("unroll") for (int m = 0; m < 4; ++m) _Pragma("unroll") for (int n = 0; n < 2; ++n) _Pragma("unroll") for (int k = 0; k < 2; ++k) \
        acc[ai][bj][m][n] = __builtin_amdgcn_mfma_f32_16x16x32_bf16(Bt[n][k], At[m][k], acc[ai][bj][m][n], 0, 0, 0); __builtin_amdgcn_s_setprio(0); } while (0)
#define PG8_WAIT_V(n) asm volatile("s_waitcnt vmcnt(" #n ")" ::: "memory")
#define PG8_WAIT_L(n) asm volatile("s_waitcnt lgkmcnt(" #n ")" ::: "memory")
#define PG8_BAR __builtin_amdgcn_s_barrier()
#define PG8_SCHED __builtin_amdgcn_sched_barrier(0)
    Unit cur, nxt; int ui = 0;
    if (!S.next(0, cur)) return;
    f32x4 acc[2][2][4][2];
#pragma unroll
    for (int a = 0; a < 2; ++a)
#pragma unroll
        for (int b = 0; b < 2; ++b)
#pragma unroll
            for (int m = 0; m < 4; ++m)
#pragma unroll
                for (int n = 0; n < 2; ++n) acc[a][b][m][n] = (f32x4){0.f, 0.f, 0.f, 0.f};
    bf16x8 At[4][2], B0[2][2], B1[2][2];
    const char* cA = (const char*)g.A + (size_t)cur.pm * tstep; const char* cB = (const char*)g.Bt + (size_t)cur.pn * tstep;
    S.a_ready(cur);
    if constexpr (SP2) {
        PG8_STAGE(PG8_SB(0, 0), cB, voffB); PG8_STAGE(PG8_SB(0, 1), cB + hstep, voffB); PG8_STAGE(PG8_SA(0, 0), cA, voffA); PG8_STAGE(PG8_SA(0, 1), cA + hstep, voffA);
        if (wr == 1) PG8_BAR;
        PG8_WAIT_V(2); PG8_BAR;
        PG8_STAGE(PG8_SB(1, 0), cB + kstep, voffB); PG8_STAGE(PG8_SA(1, 0), cA + kstep, voffA); PG8_STAGE(PG8_SB(1, 1), cB + hstep + kstep, voffB);
        PG8_WAIT_V(6); PG8_BAR;
    } else {
        PG8_STAGE(PG8_SB(0, 0), cB, voffB); PG8_STAGE(PG8_SA(0, 0), cA, voffA); PG8_STAGE(PG8_SB(0, 1), cB + hstep, voffB); PG8_STAGE(PG8_SA(0, 1), cA + hstep, voffA);
        if (wr == 1) PG8_BAR;
        PG8_WAIT_V(4); PG8_BAR;
        PG8_STAGE(PG8_SB(1, 0), cB + kstep, voffB); PG8_STAGE(PG8_SA(1, 0), cA + kstep, voffA); PG8_STAGE(PG8_SB(1, 1), cB + hstep + kstep, voffB);
        PG8_WAIT_V(6); PG8_BAR;
    }
    for (;;) {
        const bool has_next = S.next(ui + 1, nxt);
        const char* nA = has_next ? (const char*)g.A + (size_t)nxt.pm * tstep : cA; const char* nB = has_next ? (const char*)g.Bt + (size_t)nxt.pn * tstep : cB;
        for (int t = 0; t < nt; t += 2) {
            const bool last = (t == nt - 2);
            const char* a1 = cA + (size_t)(t + 1) * kstep;
            const char* a2 = last ? nA : cA + (size_t)(t + 2) * kstep; const char* b2 = last ? nB : cB + (size_t)(t + 2) * kstep;
            const char* a3 = a2 + kstep; const char* b3 = b2 + kstep;
            if (last && has_next) S.a_ready(nxt);
            if constexpr (SP2) {
            PG8_LDB(B0, 0, 0); PG8_LDB(B1, 0, 1); PG8_SCHED; PG8_LDA(At, 0, 0); PG8_STAGE(PG8_SA(1, 1), a1 + hstep, voffA);
            PG8_WAIT_V(8); PG8_WAIT_L(0); PG8_BAR; PG8_MMA(0, 0, At, B0); PG8_MMA(0, 1, At, B1); PG8_BAR; PG8_SCHED;
            PG8_LDA(At, 0, 1); PG8_STAGE(PG8_SB(0, 0), b2, voffB); PG8_STAGE(PG8_SB(0, 1), b2 + hstep, voffB); PG8_STAGE(PG8_SA(0, 0), a2, voffA);
            PG8_WAIT_V(8); PG8_WAIT_L(0); PG8_BAR; PG8_MMA(1, 0, At, B0); PG8_MMA(1, 1, At, B1); PG8_BAR; PG8_SCHED;
            PG8_LDB(B0, 1, 0); PG8_LDB(B1, 1, 1); PG8_SCHED; PG8_LDA(At, 1, 0); PG8_STAGE(PG8_SA(0, 1), a2 + hstep, voffA);
            PG8_WAIT_V(8); PG8_WAIT_L(0); PG8_BAR; PG8_MMA(0, 0, At, B0); PG8_MMA(0, 1, At, B1); PG8_BAR; PG8_SCHED;
            PG8_LDA(At, 1, 1); PG8_STAGE(PG8_SB(1, 0), b3, voffB); PG8_STAGE(PG8_SB(1, 1), b3 + hstep, voffB); PG8_STAGE(PG8_SA(1, 0), a3, voffA);
            PG8_WAIT_V(8); PG8_WAIT_L(0); PG8_BAR; PG8_MMA(1, 0, At, B0); PG8_MMA(1, 1, At, B1); PG8_BAR; PG8_SCHED;
            } else {
            PG8_LDB(B0, 0, 0); PG8_SCHED; PG8_LDA(At, 0, 0); PG8_STAGE(PG8_SA(1, 1), a1 + hstep, voffA);
            PG8_WAIT_L(8); PG8_BAR; PG8_WAIT_L(0); PG8_MMA(0, 0, At, B0); PG8_BAR; PG8_SCHED;
            PG8_LDB(B1, 0, 1); PG8_STAGE(PG8_SB(0, 0), b2, voffB);
            PG8_BAR; PG8_WAIT_L(0); PG8_MMA(0, 1, At, B1); PG8_BAR;
            PG8_LDA(At, 0, 1); PG8_STAGE(PG8_SA(0, 0), a2, voffA);
            PG8_BAR; PG8_WAIT_L(0); PG8_MMA(1, 0, At, B0); PG8_BAR; PG8_SCHED;
            PG8_STAGE(PG8_SB(0, 1), b2 + hstep, voffB);
            PG8_WAIT_V(6); PG8_BAR; PG8_MMA(1, 1, At, B1); PG8_BAR;
            PG8_LDB(B0, 1, 0); PG8_SCHED; PG8_LDA(At, 1, 0); PG8_STAGE(PG8_SA(0, 1), a2 + hstep, voffA);
            PG8_WAIT_L(8); PG8_BAR; PG8_WAIT_L(0); PG8_MMA(0, 0, At, B0); PG8_BAR; PG8_SCHED;
            PG8_LDB(B1, 1, 1); PG8_STAGE(PG8_SB(1, 0), b3, voffB);
            PG8_BAR; PG8_WAIT_L(0); PG8_MMA(0, 1, At, B1); PG8_BAR;
            PG8_LDA(At, 1, 1); PG8_STAGE(PG8_SA(1, 0), a3, voffA);
            PG8_BAR; PG8_WAIT_L(0); PG8_MMA(1, 0, At, B0); PG8_BAR; PG8_SCHED;
            PG8_STAGE(PG8_SB(1, 1), b3 + hstep, voffB);
            PG8_WAIT_V(6); PG8_BAR; PG8_MMA(1, 1, At, B1); PG8_BAR;
            }
        }
        if constexpr (ALIGN_EPI) { if (wr == 0) PG8_BAR; }
        if constexpr (!Epi::AFTER_DRAIN) { E(acc, cur, wr, wc, fr, fq); S.done(cur); }
        if (!has_next) break;
#pragma unroll
        for (int a = 0; a < 2; ++a)
#pragma unroll
            for (int b = 0; b < 2; ++b)
#pragma unroll
                for (int m = 0; m < 4; ++m)
#pragma unroll
                    for (int n = 0; n < 2; ++n) acc[a][b][m][n] = (f32x4){0.f, 0.f, 0.f, 0.f};
        cur = nxt; cA = nA; cB = nB; ++ui;
        if constexpr (ALIGN_EPI) { if (wr == 1) PG8_BAR; }
    }
    PG8_WAIT_V(0);
    if constexpr (!ALIGN_EPI) { if (wr == 0) PG8_BAR; }
    PG8_BAR;
    if constexpr (Epi::AFTER_DRAIN) { E.fused(acc, cur, wr, wc, fr, fq, lds, wid, lane); S.done(cur); }
#undef PG8_SA
#undef PG8_SB
#undef PG8_STAGE
#undef PG8_LDA
#undef PG8_LDB
#undef PG8_MMA
#undef PG8_WAIT_V
#undef PG8_WAIT_L
#undef PG8_BAR
#undef PG8_SCHED
}
}

#ifndef PG8_SP2
#define PG8_SP2 true
#endif
#ifndef PG8_ALIGN
#define PG8_ALIGN true
#endif
#include <hip/hip_cooperative_groups.h>
namespace cg = cooperative_groups;

constexpr int BATCH = 8, SEQ = 2048, D = 1024, M = BATCH * SEQ, FF = 2816, PLE = 256, DEPTH = 2;
constexpr float EPS = 1e-6f;
constexpr float LOG2E = 1.4426950408889634f;
constexpr int NWAVES = 8;
constexpr int LDS_BYTES = 147456;
#define LAS __attribute__((address_space(3)))
typedef unsigned short bf16_t;
typedef float f32x4 __attribute__((ext_vector_type(4)));
typedef unsigned u32x4 __attribute__((ext_vector_type(4)));
typedef unsigned u32x2 __attribute__((ext_vector_type(2)));
typedef short bf16x8 __attribute__((ext_vector_type(8)));
typedef float f32x16 __attribute__((ext_vector_type(16)));

constexpr size_t MiB = 1u << 20;
constexpr size_t WS_CTL = 0;
constexpr size_t WS_W1IN = 1 * MiB;
constexpr size_t WS_W1OUT = WS_W1IN + (size_t)2 * FF * D * 2;
constexpr size_t WS_W2IN = WS_W1OUT + (size_t)D * FF * 2;
constexpr size_t WS_W2OUT = WS_W2IN + (size_t)2 * FF * D * 2;
constexpr size_t WS_WQKV = WS_W2OUT + (size_t)D * FF * 2;
constexpr size_t WS_WO = WS_WQKV + (size_t)3 * D * D * 2;
constexpr size_t WS_WPROJ = WS_WO + (size_t)D * D * 2;
constexpr size_t WS_WGATE = WS_WPROJ + (size_t)D * PLE * 2;
constexpr size_t WS_WEND = WS_WGATE + (size_t)D * D * 2;
static_assert(WS_WEND <= 48 * MiB, "weights");
constexpr size_t WS_Y = 48 * MiB;
constexpr size_t WS_QK = 112 * MiB;
constexpr size_t WS_VT = 176 * MiB;
constexpr size_t WS_H = 112 * MiB;
constexpr size_t WS_E = 112 * MiB;
constexpr size_t WS_XN = 208 * MiB;
constexpr size_t WS_PB = 240 * MiB;
constexpr size_t WS_END = 248 * MiB;

__device__ __forceinline__ unsigned pk2bf(float lo, float hi) {
    typedef float f2 __attribute__((ext_vector_type(2))); typedef __bf16 b2 __attribute__((ext_vector_type(2)));
    f2 v = {lo, hi}; b2 b = __builtin_convertvector(v, b2); return __builtin_bit_cast(unsigned, b);
}
__device__ __forceinline__ float bf2f(unsigned short h) { return __builtin_bit_cast(float, (unsigned)h << 16); }
__device__ __forceinline__ float wave_sum(float v) {
#pragma unroll
    for (int o = 1; o < 64; o <<= 1) v += __shfl_xor(v, o);
    return v;
}
__device__ __forceinline__ float fast_sigmoid(float x) { return __builtin_amdgcn_rcpf(1.0f + __builtin_amdgcn_exp2f(-x * LOG2E)); }

struct EpiF32 {
    static constexpr bool PERM = false, AFTER_DRAIN = false;
    float* out; int ldc;
    __device__ __forceinline__ void operator()(const pg8::f32x4 (&acc)[2][2][4][2], const pg8::Unit& u, int wr, int wc, int fr, int fq) const {
        const int col0 = u.pn * 256 + wc * 32 + 4 * fq;
#pragma unroll
        for (int ai = 0; ai < 2; ++ai)
#pragma unroll
            for (int m = 0; m < 4; ++m) { float* rowp = out + (size_t)(u.pm * 256 + ai * 128 + wr * 64 + m * 16 + fr) * ldc + col0;
#pragma unroll
                for (int bj = 0; bj < 2; ++bj)
#pragma unroll
                    for (int n = 0; n < 2; ++n) *(pg8::f32x4*)(rowp + bj * 128 + n * 16) = acc[ai][bj][m][n]; }
    }
};
struct EpiBf {
    static constexpr bool PERM = true, AFTER_DRAIN = false;
    bf16_t* out; int ldc;
    __device__ __forceinline__ void operator()(const pg8::f32x4 (&acc)[2][2][4][2], const pg8::Unit& u, int wr, int wc, int fr, int fq) const {
        const int col0 = u.pn * 256 + wc * 32 + 8 * fq;
#pragma unroll
        for (int ai = 0; ai < 2; ++ai)
#pragma unroll
            for (int m = 0; m < 4; ++m) { bf16_t* rowp = out + (size_t)(u.pm * 256 + ai * 128 + wr * 64 + m * 16 + fr) * ldc + col0;
#pragma unroll
                for (int bj = 0; bj < 2; ++bj) { const pg8::f32x4 v0 = acc[ai][bj][m][0], v1 = acc[ai][bj][m][1]; u32x4 w;
                    w.x = pk2bf(v0[0], v0[1]); w.y = pk2bf(v0[2], v0[3]); w.z = pk2bf(v1[0], v1[1]); w.w = pk2bf(v1[2], v1[3]);
                    *(u32x4*)(rowp + bj * 128) = w; } }
    }
};
struct EpiSwiglu {
    static constexpr bool PERM = true, AFTER_DRAIN = false;
    bf16_t* out;
    __device__ __forceinline__ void operator()(const pg8::f32x4 (&acc)[2][2][4][2], const pg8::Unit& u, int wr, int wc, int fr, int fq) const {
        const int col0 = u.pn * 128 + wc * 32 + 8 * fq;
#pragma unroll
        for (int ai = 0; ai < 2; ++ai)
#pragma unroll
            for (int m = 0; m < 4; ++m) { bf16_t* rowp = out + (size_t)(u.pm * 256 + ai * 128 + wr * 64 + m * 16 + fr) * FF + col0;
                float h[8];
#pragma unroll
                for (int n = 0; n < 2; ++n)
#pragma unroll
                    for (int j = 0; j < 4; ++j) { const float a = acc[ai][0][m][n][j], b = acc[ai][1][m][n][j]; h[n * 4 + j] = a * fast_sigmoid(a) * b; }
                u32x4 w; w.x = pk2bf(h[0], h[1]); w.y = pk2bf(h[2], h[3]); w.z = pk2bf(h[4], h[5]); w.w = pk2bf(h[6], h[7]);
                *(u32x4*)rowp = w; }
    }
};
struct EpiGate {
    static constexpr bool PERM = false, AFTER_DRAIN = false;
    float* out; const bf16_t* E;
    __device__ __forceinline__ void operator()(const pg8::f32x4 (&acc)[2][2][4][2], const pg8::Unit& u, int wr, int wc, int fr, int fq) const {
        const int col0 = u.pn * 256 + wc * 32 + 4 * fq;
#pragma unroll
        for (int ai = 0; ai < 2; ++ai)
#pragma unroll
            for (int m = 0; m < 4; ++m) { const size_t off = (size_t)(u.pm * 256 + ai * 128 + wr * 64 + m * 16 + fr) * D + col0;
#pragma unroll
                for (int bj = 0; bj < 2; ++bj)
#pragma unroll
                    for (int n = 0; n < 2; ++n) { const u32x2 ev = *(const u32x2*)(E + off + bj * 128 + n * 16); const pg8::f32x4 a = acc[ai][bj][m][n]; pg8::f32x4 o;
                        o[0] = fast_sigmoid(a[0]) * __builtin_bit_cast(float, ev.x << 16); o[1] = fast_sigmoid(a[1]) * __builtin_bit_cast(float, ev.x & 0xffff0000u);
                        o[2] = fast_sigmoid(a[2]) * __builtin_bit_cast(float, ev.y << 16); o[3] = fast_sigmoid(a[3]) * __builtin_bit_cast(float, ev.y & 0xffff0000u);
                        *(pg8::f32x4*)(out + off + bj * 128 + n * 16) = o; } }
    }
};

template <int MODE>
__device__ __forceinline__ void transpose_item(const float* W, int K, int N, bf16_t* WT, LAS float* scr, int item, int lane) {
    const int nblk = N / 32, kb = item / nblk, nb = item % nblk, k0 = 64 * kb, n0 = 32 * nb;
#pragma unroll 8
    for (int i = 0; i < 32; ++i) { const int kk = 2 * i + (lane >> 5); scr[kk * 33 + (lane & 31)] = W[(size_t)(k0 + kk) * N + n0 + (lane & 31)]; }
    asm volatile("s_waitcnt lgkmcnt(0)" ::: "memory");
    int r0 = n0;
    if (MODE == 1) { const int half = n0 >= FF ? 1 : 0; const int j = n0 - half * FF; r0 = (j >> 7) * 256 + half * 128 + (j & 127); }
    const int c = lane & 7;
#pragma unroll
    for (int j = 0; j < 4; ++j) { const int n = (lane >> 3) + 8 * j; const LAS float* s = scr + (8 * c) * 33 + n;
        u32x4 o; o.x = pk2bf(s[0 * 33], s[1 * 33]); o.y = pk2bf(s[2 * 33], s[3 * 33]); o.z = pk2bf(s[4 * 33], s[5 * 33]); o.w = pk2bf(s[6 * 33], s[7 * 33]);
        *(u32x4*)(WT + (size_t)(r0 + n) * K + k0 + 8 * c) = o; }
    asm volatile("s_waitcnt lgkmcnt(0)" ::: "memory");
}

struct LayerW { const float *w1in, *w1out, *w2in, *w2out, *wqkv, *wo, *wproj, *wgate; };
__device__ __forceinline__ void convert_weights(const LayerW& L, unsigned char* ws, LAS float* scr, int gw, int NGW, int lane) {
    constexpr int I_IN = (D / 64) * (2 * FF / 32), I_OUT = (FF / 64) * (D / 32), I_QKV = (D / 64) * (3 * D / 32), I_O = (D / 64) * (D / 32), I_P = (PLE / 64) * (D / 32);
    constexpr int NITEMS = 2 * I_IN + 2 * I_OUT + I_QKV + 2 * I_O + I_P;
    for (int it = gw; it < NITEMS; it += NGW) {
        int r = it;
        if (r < I_IN) { transpose_item<1>(L.w1in, D, 2 * FF, (bf16_t*)(ws + WS_W1IN), scr, r, lane); continue; } r -= I_IN;
        if (r < I_IN) { transpose_item<1>(L.w2in, D, 2 * FF, (bf16_t*)(ws + WS_W2IN), scr, r, lane); continue; } r -= I_IN;
        if (r < I_OUT) { transpose_item<0>(L.w1out, FF, D, (bf16_t*)(ws + WS_W1OUT), scr, r, lane); continue; } r -= I_OUT;
        if (r < I_OUT) { transpose_item<0>(L.w2out, FF, D, (bf16_t*)(ws + WS_W2OUT), scr, r, lane); continue; } r -= I_OUT;
        if (r < I_QKV) { transpose_item<0>(L.wqkv, D, 3 * D, (bf16_t*)(ws + WS_WQKV), scr, r, lane); continue; } r -= I_QKV;
        if (r < I_O) { transpose_item<0>(L.wo, D, D, (bf16_t*)(ws + WS_WO), scr, r, lane); continue; } r -= I_O;
        if (r < I_O) { transpose_item<0>(L.wgate, D, D, (bf16_t*)(ws + WS_WGATE), scr, r, lane); continue; } r -= I_O;
        transpose_item<0>(L.wproj, PLE, D, (bf16_t*)(ws + WS_WPROJ), scr, r, lane);
    }
}

__device__ __forceinline__ void rows_phase(const float* Y, float coef, const float* gpost, const float* gpre, const float* xin, float* xout, bf16_t* XN, int gw, int NGW, int lane) {
    for (int m = gw; m < M; m += NGW) {
        const f32x4* xr = (const f32x4*)(xin + (size_t)m * D) + lane;
        f32x4 xv[4];
#pragma unroll
        for (int j = 0; j < 4; ++j) xv[j] = xr[64 * j];
        if (Y) {
            const f32x4* yr = (const f32x4*)(Y + (size_t)m * D) + lane; f32x4 yv[4]; float ss = 0.f;
#pragma unroll
            for (int j = 0; j < 4; ++j) { yv[j] = yr[64 * j]; ss += (yv[j].x * yv[j].x + yv[j].y * yv[j].y) + (yv[j].z * yv[j].z + yv[j].w * yv[j].w); }
            const float r = coef * __builtin_amdgcn_rsqf(wave_sum(ss) * (1.f / D) + EPS);
#pragma unroll
            for (int j = 0; j < 4; ++j) { const f32x4 g = ((const f32x4*)gpost)[lane + 64 * j]; xv[j] = xv[j] + yv[j] * g * r; }
        }
        if (Y || xin != xout) { f32x4* xo = (f32x4*)(xout + (size_t)m * D) + lane;
#pragma unroll
            for (int j = 0; j < 4; ++j) xo[64 * j] = xv[j]; }
        if (gpre) {
            float ss = 0.f;
#pragma unroll
            for (int j = 0; j < 4; ++j) ss += (xv[j].x * xv[j].x + xv[j].y * xv[j].y) + (xv[j].z * xv[j].z + xv[j].w * xv[j].w);
            const float r = __builtin_amdgcn_rsqf(wave_sum(ss) * (1.f / D) + EPS);
            u32x2* o8 = (u32x2*)(XN + (size_t)m * D) + lane;
#pragma unroll
            for (int j = 0; j < 4; ++j) { const f32x4 g = ((const f32x4*)gpre)[lane + 64 * j]; const f32x4 v = xv[j] * g * r; u32x2 w; w.x = pk2bf(v.x, v.y); w.y = pk2bf(v.z, v.w); o8[64 * j] = w; }
        }
    }
}
__device__ __forceinline__ void p_to_bf16(const float* P, bf16_t* PB, int gw, int NGW, int lane) {
    for (int m = gw; m < M; m += NGW) { const f32x4 v = ((const f32x4*)(P + (size_t)m * PLE))[lane]; u32x2 w; w.x = pk2bf(v.x, v.y); w.y = pk2bf(v.z, v.w); ((u32x2*)(PB + (size_t)m * PLE))[lane] = w; }
}

__device__ __forceinline__ int crow(int r, int hb) { return (r & 3) + 8 * (r >> 2) + 4 * hb; }
__device__ __forceinline__ int swap23(int i) { return (i & ~12) | ((i & 4) << 1) | ((i & 8) >> 1); }
#define MFMA32(a, b, c) __builtin_amdgcn_mfma_f32_32x32x16_bf16((a), (b), (c), 0, 0, 0)

__device__ __forceinline__ void da_unit(const bf16_t* QK, const bf16_t* VT, bf16_t* O, int b, int h, int qb, int c, float lam, float slope2,
                                        const float* subln_g, float outscale, LAS float* xch, LAS unsigned char* stg, int lane) {
    const int r32 = lane & 31, hb = lane >> 5;
    const size_t tok0 = (size_t)b * SEQ;
    const bf16_t* qp = QK + (tok0 + 32 * qb + r32) * 2048 + h * 128 + c * 64 + 8 * hb;
    bf16x8 qf[4];
#pragma unroll
    for (int d0 = 0; d0 < 4; ++d0) qf[d0] = *(const bf16x8*)(qp + 16 * d0);
    f32x16 o[4];
#pragma unroll
    for (int eb = 0; eb < 4; ++eb)
#pragma unroll
        for (int r = 0; r < 16; ++r) o[eb][r] = 0.f;
    float mref = -INFINITY, l = 0.f;
    const int nkb = 2 * ((qb >> 1) + 1);
    const int tq = 32 * qb + r32;
    const bf16_t* kbase = QK + (tok0 + swap23(r32)) * 2048 + 1024 + h * 128 + c * 64 + 8 * hb;
    const bf16_t* vbase = VT + (size_t)(h * 128 + r32) * M + tok0 + 8 * hb;
    constexpr float SC2 = 0.125f * LOG2E;
    bf16x8 kfn[4];
    {   const bf16_t* kp = kbase + (size_t)(32 * (nkb - 1)) * 2048;
#pragma unroll
        for (int d0 = 0; d0 < 4; ++d0) kfn[d0] = *(const bf16x8*)(kp + 16 * d0); }
    for (int kb = nkb - 1; kb >= 0; --kb) {
        bf16x8 kf[4], vf[4][2];
#pragma unroll
        for (int d0 = 0; d0 < 4; ++d0) kf[d0] = kfn[d0];
#pragma unroll
        for (int eb = 0; eb < 4; ++eb)
#pragma unroll
            for (int ks = 0; ks < 2; ++ks) vf[eb][ks] = *(const bf16x8*)(vbase + (size_t)(32 * eb) * M + 32 * kb + 16 * ks);
        {   const int kn = kb > 0 ? kb - 1 : 0;
            const bf16_t* kp = kbase + (size_t)(32 * kn) * 2048;
#pragma unroll
            for (int d0 = 0; d0 < 4; ++d0) kfn[d0] = *(const bf16x8*)(kp + 16 * d0); }
        f32x16 s;
#pragma unroll
        for (int r = 0; r < 16; ++r) s[r] = 0.f;
#pragma unroll
        for (int d0 = 0; d0 < 4; ++d0) s = MFMA32(kf[d0], qf[d0], s);
        const int dq = tq - (32 * kb + 8 * hb);
        float bm = -INFINITY;
#pragma unroll
        for (int r = 0; r < 16; ++r) { const int dd = dq - (16 * (r >> 3) + (r & 7)); const float dist = (float)(dd < 0 ? -dd : dd); s[r] = s[r] * SC2 - slope2 * dist; bm = fmaxf(bm, s[r]); }
        bm = fmaxf(bm, __shfl_xor(bm, 32));
        if (__any(bm > mref + 8.0f)) {
            const float mn = fmaxf(mref, bm); const float al = __builtin_amdgcn_exp2f(mref - mn); l *= al;
#pragma unroll
            for (int eb = 0; eb < 4; ++eb)
#pragma unroll
                for (int r = 0; r < 16; ++r) o[eb][r] *= al;
            mref = mn;
        }
        float ps = 0.f;
#pragma unroll
        for (int r = 0; r < 16; ++r) { s[r] = __builtin_amdgcn_exp2f(s[r] - mref); ps += s[r]; }
        l += ps;
        bf16x8 pb[2];
#pragma unroll
        for (int ks = 0; ks < 2; ++ks) { u32x4 w; w.x = pk2bf(s[8 * ks + 0], s[8 * ks + 1]); w.y = pk2bf(s[8 * ks + 2], s[8 * ks + 3]); w.z = pk2bf(s[8 * ks + 4], s[8 * ks + 5]); w.w = pk2bf(s[8 * ks + 6], s[8 * ks + 7]); pb[ks] = __builtin_bit_cast(bf16x8, w); }
#pragma unroll
        for (int eb = 0; eb < 4; ++eb)
#pragma unroll
            for (int ks = 0; ks < 2; ++ks) o[eb] = MFMA32(vf[eb][ks], pb[ks], o[eb]);
    }
    l += __shfl_xor(l, 32);
    const float inv = 1.0f / l;
    if (c == 1) { const float w = -lam * inv;
#pragma unroll
        for (int eb = 0; eb < 4; ++eb)
#pragma unroll
            for (int r = 0; r < 16; ++r) xch[(eb * 16 + r) * 64 + lane] = o[eb][r] * w; }
    __syncthreads();
    if (c == 0) {
        float ss = 0.f;
#pragma unroll
        for (int eb = 0; eb < 4; ++eb)
#pragma unroll
            for (int r = 0; r < 16; ++r) { const float v = o[eb][r] * inv + xch[(eb * 16 + r) * 64 + lane]; o[eb][r] = v; ss += v * v; }
        ss += __shfl_xor(ss, 32);
        const float rn = __builtin_amdgcn_rsqf(ss * (1.f / 128.f) + EPS) * outscale;
#pragma unroll
        for (int eb = 0; eb < 4; ++eb)
#pragma unroll
            for (int r = 0; r < 16; r += 2) { const int e = 32 * eb + crow(r, hb); const float v0 = o[eb][r] * rn * subln_g[e], v1 = o[eb][r + 1] * rn * subln_g[e + 1];
                *(LAS unsigned*)(stg + r32 * 272 + e * 2) = pk2bf(v0, v1); }
        asm volatile("s_waitcnt lgkmcnt(0)" ::: "memory");
#pragma unroll
        for (int i = 0; i < 8; ++i) { const int idx = i * 64 + lane, row = idx >> 4, ch = idx & 15; const u32x4 v = *(const LAS u32x4*)(stg + row * 272 + ch * 16);
            *(u32x4*)(O + (tok0 + 32 * qb + row) * D + h * 128 + ch * 8) = v; }
    }
    __syncthreads();
}

__device__ __forceinline__ void sb_unit(const bf16_t* QK, const bf16_t* VT, bf16_t* O, int b, int h, int qb, LAS unsigned char* stg, int lane) {
    const int r32 = lane & 31, hb = lane >> 5;
    const size_t tok0 = (size_t)b * SEQ;
    const bf16_t* qp = QK + (tok0 + 32 * qb + r32) * 2048 + h * 64 + 8 * hb;
    bf16x8 qf[4];
#pragma unroll
    for (int d0 = 0; d0 < 4; ++d0) qf[d0] = *(const bf16x8*)(qp + 16 * d0);
    f32x16 o[2];
#pragma unroll
    for (int eb = 0; eb < 2; ++eb)
#pragma unroll
        for (int r = 0; r < 16; ++r) o[eb][r] = 0.f;
    float carry = 1.0f;
    const bf16_t* kbase = QK + (tok0 + swap23(r32)) * 2048 + 1024 + h * 64 + 8 * hb;
    const bf16_t* vbase = VT + (size_t)(h * 64 + r32) * M + tok0 + 8 * hb;
    constexpr float SC2 = 0.125f * LOG2E;
    bf16x8 kfn[4], vfn[2][2];
    {   const bf16_t* kp = kbase + (size_t)(32 * qb) * 2048;
#pragma unroll
        for (int d0 = 0; d0 < 4; ++d0) kfn[d0] = *(const bf16x8*)(kp + 16 * d0);
#pragma unroll
        for (int eb = 0; eb < 2; ++eb)
#pragma unroll
            for (int ks = 0; ks < 2; ++ks) vfn[eb][ks] = *(const bf16x8*)(vbase + (size_t)(32 * eb) * M + 32 * qb + 16 * ks); }
    for (int kb = qb; kb >= 0; --kb) {
        if (__all(carry == 0.0f)) break;
        bf16x8 kf[4], vf[2][2];
#pragma unroll
        for (int d0 = 0; d0 < 4; ++d0) kf[d0] = kfn[d0];
#pragma unroll
        for (int eb = 0; eb < 2; ++eb)
#pragma unroll
            for (int ks = 0; ks < 2; ++ks) vf[eb][ks] = vfn[eb][ks];
        {   const int kn = kb > 0 ? kb - 1 : 0;
            const bf16_t* kp = kbase + (size_t)(32 * kn) * 2048;
#pragma unroll
            for (int d0 = 0; d0 < 4; ++d0) kfn[d0] = *(const bf16x8*)(kp + 16 * d0);
#pragma unroll
            for (int eb = 0; eb < 2; ++eb)
#pragma unroll
                for (int ks = 0; ks < 2; ++ks) vfn[eb][ks] = *(const bf16x8*)(vbase + (size_t)(32 * eb) * M + 32 * kn + 16 * ks); }
        f32x16 s;
#pragma unroll
        for (int r = 0; r < 16; ++r) s[r] = 0.f;
#pragma unroll
        for (int d0 = 0; d0 < 4; ++d0) s = MFMA32(kf[d0], qf[d0], s);
        float om[16];
#pragma unroll
        for (int r = 0; r < 16; ++r) { const float e = __builtin_amdgcn_exp2f(s[r] * SC2); om[r] = __builtin_amdgcn_rcpf(1.0f + e); }
        if (kb == qb) {
            const int dq = r32 - 8 * hb;
#pragma unroll
            for (int r = 0; r < 16; ++r) { if (dq - (16 * (r >> 3) + (r & 7)) <= 0) om[r] = 1.0f; }
        }
        float sufA[8], sufB[8];
        sufA[7] = 1.0f; sufB[7] = 1.0f;
#pragma unroll
        for (int j = 6; j >= 0; --j) { sufA[j] = sufA[j + 1] * om[j + 1]; sufB[j] = sufB[j + 1] * om[8 + j + 1]; }
        const float TA = sufA[0] * om[0], TB = sufB[0] * om[8];
        const float pTA = __shfl_xor(TA, 32), pTB = __shfl_xor(TB, 32);
        const float multB = hb ? carry : carry * pTB;
        const float multA = hb ? carry * TB * pTB : carry * pTB * TB * pTA;
        carry = carry * ((TA * TB) * (pTA * pTB));
        float a[16];
#pragma unroll
        for (int j = 0; j < 8; ++j) { a[j] = (1.0f - om[j]) * sufA[j] * multA; a[8 + j] = (1.0f - om[8 + j]) * sufB[j] * multB; }
        bf16x8 pb[2];
#pragma unroll
        for (int ks = 0; ks < 2; ++ks) { u32x4 w; w.x = pk2bf(a[8 * ks + 0], a[8 * ks + 1]); w.y = pk2bf(a[8 * ks + 2], a[8 * ks + 3]); w.z = pk2bf(a[8 * ks + 4], a[8 * ks + 5]); w.w = pk2bf(a[8 * ks + 6], a[8 * ks + 7]); pb[ks] = __builtin_bit_cast(bf16x8, w); }
#pragma unroll
        for (int eb = 0; eb < 2; ++eb)
#pragma unroll
            for (int ks = 0; ks < 2; ++ks) o[eb] = MFMA32(vf[eb][ks], pb[ks], o[eb]);
    }
#pragma unroll
    for (int eb = 0; eb < 2; ++eb)
#pragma unroll
        for (int r = 0; r < 16; r += 2) { const int e = 32 * eb + crow(r, hb); *(LAS unsigned*)(stg + r32 * 144 + e * 2) = pk2bf(o[eb][r], o[eb][r + 1]); }
    asm volatile("s_waitcnt lgkmcnt(0)" ::: "memory");
#pragma unroll
    for (int i = 0; i < 4; ++i) { const int idx = i * 64 + lane, row = idx >> 3, ch = idx & 7; const u32x4 v = *(const LAS u32x4*)(stg + row * 144 + ch * 16);
        *(u32x4*)(O + (tok0 + 32 * qb + row) * D + h * 64 + ch * 8) = v; }
    asm volatile("s_waitcnt lgkmcnt(0)" ::: "memory");
}

#define XB_TMO      128
#define XB_XCNT(j)  (256  + 64 * (j))
#define XB_XSUB(j)  (1280 + 64 * (j))
#define XB_XGEN(j)  (2304 + 64 * (j))
#define XB_TOP      3328
#define XB_TOPGEN   3392
#define XCD_BAR_WORDS 3456
#define XB_SPIN_CAP (1u << 18)

__device__ __forceinline__ unsigned xb_ld(unsigned* p)              { return __hip_atomic_load(p, __ATOMIC_RELAXED, __HIP_MEMORY_SCOPE_AGENT); }
__device__ __forceinline__ unsigned xb_add(unsigned* p, unsigned v) { return __hip_atomic_fetch_add(p, v, __ATOMIC_RELAXED, __HIP_MEMORY_SCOPE_AGENT); }
__device__ __forceinline__ unsigned xb_xcc_id() { return (unsigned)__builtin_amdgcn_s_getreg((3 << 11) | 20) & 0xFu; }
#define XB_SPIN(cond, bar) do { unsigned _sp = 0; while (cond) { __builtin_amdgcn_s_sleep(1); \
    if ((++_sp & 255u) == 0u) { if (xb_ld(&(bar)[XB_TMO])) break; if (_sp > XB_SPIN_CAP) { atomicAdd(&(bar)[XB_TMO], 1u); break; } } } } while (0)

struct XcdBarrier {
    unsigned* bar; unsigned x;
    volatile LAS unsigned* st;
};

__device__ __forceinline__ XcdBarrier xcd_barrier_post(unsigned* bar, volatile LAS unsigned* st) {
    XcdBarrier b; b.bar = bar; b.x = xb_xcc_id(); b.st = st;
    if (threadIdx.x == 0) (void)xb_add(&bar[XB_XCNT(b.x)], 1u);
    return b;
}
__device__ __forceinline__ void xcd_barrier_complete(unsigned* bar, unsigned x, unsigned& nloc, unsigned& nx) {
    const unsigned G = gridDim.x * gridDim.y * gridDim.z;
    unsigned sum, cnt, mine, sp = 0u;
    for (;;) {
        sum = 0u; cnt = 0u; mine = 0u;
#pragma unroll
        for (unsigned j = 0; j < 16; ++j) { const unsigned c = xb_ld(&bar[XB_XCNT(j)]); sum += c; cnt += (c > 0u) ? 1u : 0u; mine = (j == x) ? c : mine; }
        if (sum == G) break;
        __builtin_amdgcn_s_sleep(1);
        if ((++sp & 255u) == 0u) { if (xb_ld(&bar[XB_TMO])) break; if (sp > XB_SPIN_CAP) { atomicAdd(&bar[XB_TMO], 1u); break; } }
    }
    nloc = mine > 0u ? mine : 1u; nx = cnt > 0u ? cnt : 1u;
}

__device__ __forceinline__ void xcd_barrier(const XcdBarrier& b) {
    asm volatile("s_waitcnt vmcnt(0)" ::: "memory");
    __syncthreads();
    if (threadIdx.x == 0) {
        unsigned* bar = b.bar;
        __builtin_amdgcn_s_waitcnt(0);
        unsigned nloc = b.st[0], nx = b.st[1];
        if (nloc == 0u) { xcd_barrier_complete(bar, b.x, nloc, nx); b.st[0] = nloc; b.st[1] = nx; }
        const unsigned old = xb_add(&bar[XB_XSUB(b.x)], 1u);
        const unsigned gen = old / nloc;
        if (old + 1u == (gen + 1u) * nloc) {
            __builtin_amdgcn_fence(__ATOMIC_RELEASE, "agent");
            asm volatile("s_waitcnt vmcnt(0)" ::: "memory");
            const unsigned og = xb_add(&bar[XB_TOP], 1u);
            const unsigned tg = og / nx;
            if (og + 1u == (tg + 1u) * nx) xb_add(&bar[XB_TOPGEN], 1u);
            else XB_SPIN(xb_ld(&bar[XB_TOPGEN]) == tg, bar);
            __builtin_amdgcn_fence(__ATOMIC_ACQUIRE, "agent");
            xb_add(&bar[XB_XGEN(b.x)], 1u);
            asm volatile("s_waitcnt vmcnt(0)" ::: "memory");
        } else {
            XB_SPIN(xb_ld(&bar[XB_XGEN(b.x)]) == gen, bar);
            __builtin_amdgcn_fence(__ATOMIC_ACQUIRE, "agent");
            asm volatile("s_waitcnt vmcnt(0)" ::: "memory");
        }
    }
    __syncthreads();
}

struct Args { const float* in[15]; float* out; unsigned char* ws; };
static_assert(sizeof(Args) == 15 * 8 + 8 + 8, "Args has no padding");
struct KA {
    const unsigned char* p;
    __device__ __forceinline__ KA() { p = (const unsigned char*)__builtin_amdgcn_kernarg_segment_ptr(); asm volatile("" : "+s"(p)); }
    __device__ __forceinline__ const float* in(int i) const { return *(const float* const*)(p + 8 * i); }
    __device__ __forceinline__ float* out() const { return *(float* const*)(p + 120); }
    __device__ __forceinline__ unsigned char* ws() const { return *(unsigned char* const*)(p + 128); }
};
struct WaveId { int lane, wave, gw, NGW, G, bx; };
__device__ __forceinline__ WaveId wave_id() { int t = threadIdx.x; asm volatile("" : "+v"(t)); WaveId w; w.lane = t & 63; w.wave = __builtin_amdgcn_readfirstlane(t >> 6); w.G = gridDim.x; w.bx = blockIdx.x; w.gw = w.bx * NWAVES + w.wave; w.NGW = w.G * NWAVES; return w; }
__device__ __forceinline__ void layer_weights(const KA& ka, int i, LayerW& L) { L.w1in = ka.in(3) + (size_t)i * D * 2 * FF; L.w1out = ka.in(4) + (size_t)i * FF * D; L.w2in = ka.in(5) + (size_t)i * D * 2 * FF; L.w2out = ka.in(6) + (size_t)i * FF * D;
    L.wqkv = (i == 0) ? ka.in(7) : ka.in(11); L.wo = (i == 0) ? ka.in(8) : ka.in(12); L.wproj = ka.in(13) + (size_t)i * PLE * D; L.wgate = ka.in(14) + (size_t)i * D * D; }

constexpr int MISC_OFF = 131072 + 64;
constexpr size_t WS_BAR = 16384;
#define SEAM() do { KA ka_; XcdBarrier b_; b_.bar = (unsigned*)(ka_.ws() + WS_BAR); b_.x = xb_xcc_id(); b_.st = (volatile LAS unsigned*)(lds + MISC_OFF); xcd_barrier(b_); } while (0)
#ifndef PMASK
#define PMASK 0xffff
#endif
#define EN(k) ((PMASK >> (k)) & 1)
#ifndef REP_DA
#define REP_DA 1
#endif
#ifndef REP_SB
#define REP_SB 1
#endif
#ifndef REP_GEMM
#define REP_GEMM 1
#endif
template <class Epi> __device__ __forceinline__ void run_gemm(LAS unsigned char* lds, const bf16_t* A, const bf16_t* Bt, int Mr, int Nr, int Kr, const Epi& E) {
    pg8::Gemm gm{A, Bt, Mr, Nr, Kr}; pg8::StaticOrder S; S.init(Mr, Nr, (int)gridDim.x, (int)blockIdx.x);
#pragma unroll 1
    for (int rep = 0; rep < REP_GEMM; ++rep)
    pg8::gemm_phase<Epi, pg8::StaticOrder, PG8_ALIGN, PG8_SP2>(lds, gm, S, E);
}

template <int LAYER> __device__ __forceinline__ void layer_body(LAS unsigned char* lds, cg::grid_group& grid) {
    if (EN(0)) { KA ka; unsigned char* ws = ka.ws(); EpiSwiglu E{(bf16_t*)(ws + WS_H)}; run_gemm(lds, (const bf16_t*)(ws + WS_XN), (const bf16_t*)(ws + WS_W1IN), M, 2 * FF, D, E); }
    SEAM();
    if (EN(1)) { KA ka; unsigned char* ws = ka.ws(); EpiF32 E{(float*)(ws + WS_Y), D}; run_gemm(lds, (const bf16_t*)(ws + WS_H), (const bf16_t*)(ws + WS_W1OUT), M, D, FF, E); }
    SEAM();
    if (EN(2)) { KA ka; unsigned char* ws = ka.ws(); const WaveId w = wave_id(); const float* g = ka.in(2) + (size_t)LAYER * 8 * D; float* xres = ka.out();
        rows_phase((const float*)(ws + WS_Y), 0.5f, g + 1 * D, g + 2 * D, xres, xres, (bf16_t*)(ws + WS_XN), w.gw, w.NGW, w.lane); }
    SEAM();
    if (EN(3)) {
        { KA ka; unsigned char* ws = ka.ws(); EpiBf E{(bf16_t*)(ws + WS_QK), 2 * D}; run_gemm(lds, (const bf16_t*)(ws + WS_XN), (const bf16_t*)(ws + WS_WQKV), M, 2 * D, D, E); }
        { KA ka; unsigned char* ws = ka.ws(); EpiBf E{(bf16_t*)(ws + WS_VT), M}; run_gemm(lds, (const bf16_t*)(ws + WS_WQKV) + (size_t)2 * D * D, (const bf16_t*)(ws + WS_XN), D, M, D, E); }
    }
    SEAM();
    if (EN(4)) {
        KA ka; unsigned char* ws = ka.ws(); const WaveId w = wave_id();
        const bf16_t* QK = (const bf16_t*)(ws + WS_QK); const bf16_t* VT = (const bf16_t*)(ws + WS_VT); bf16_t* O = (bf16_t*)(ws + WS_XN);
#ifndef NO_DA
        if (LAYER == 0) {
            const float* lv = ka.in(9); const float* subln = ka.in(10);
            const float lambda_init = 0.8f - 0.6f * 1.0f;
            const float s1 = wave_sum(lv[w.lane] * lv[64 + w.lane]), s2 = wave_sum(lv[128 + w.lane] * lv[192 + w.lane]);
            const float lam = __expf(s1) - __expf(s2) + lambda_init;
            const int wp = w.bx * 4 + (w.wave >> 1), c = w.wave & 1;
            const int bh = wp >> 4, j0 = (wp & 15) * 2;
            const int b = bh >> 3, h = bh & 7;
            const float slope2 = exp2f(-(float)(h + 1)) * LOG2E;
            LAS float* xch = (LAS float*)(lds + (w.wave >> 1) * 32768);
            LAS unsigned char* stg = lds + (w.wave >> 1) * 32768 + 16384;
#pragma unroll 1
            for (int u = 0; u < 4 * REP_DA; ++u) { const int j = j0 + ((u & 3) >> 1); const int qb = (u & 1) ? 63 - j : j;
                da_unit(QK, VT, O, b, h, qb, c, lam, slope2, subln, 1.0f - lambda_init, xch, stg, w.lane); }
        }
#endif
#ifndef NO_SB
        if (LAYER == 1) {
            const int bh = w.gw >> 4, j0 = (w.gw & 15) * 2;
            const int b = bh >> 4, h = bh & 15;
            LAS unsigned char* stg = lds + w.wave * 8192;
#pragma unroll 1
            for (int u = 0; u < 4 * REP_SB; ++u) { const int j = j0 + ((u & 3) >> 1); const int qb = (u & 1) ? 63 - j : j;
                sb_unit(QK, VT, O, b, h, qb, stg, w.lane); }
        }
#endif
    }
    SEAM();
    if (EN(5)) { KA ka; unsigned char* ws = ka.ws(); EpiF32 E{(float*)(ws + WS_Y), D}; run_gemm(lds, (const bf16_t*)(ws + WS_XN), (const bf16_t*)(ws + WS_WO), M, D, D, E); }
    SEAM();
    if (EN(6)) { KA ka; unsigned char* ws = ka.ws(); const WaveId w = wave_id(); const float* g = ka.in(2) + (size_t)LAYER * 8 * D; float* xres = ka.out();
        rows_phase((const float*)(ws + WS_Y), 1.0f, g + 3 * D, g + 4 * D, xres, xres, (bf16_t*)(ws + WS_XN), w.gw, w.NGW, w.lane);
        p_to_bf16(ka.in(1) + (size_t)LAYER * M * PLE, (bf16_t*)(ws + WS_PB), w.gw, w.NGW, w.lane); }
    SEAM();
    if (EN(7)) { KA ka; unsigned char* ws = ka.ws(); EpiSwiglu E{(bf16_t*)(ws + WS_H)}; run_gemm(lds, (const bf16_t*)(ws + WS_XN), (const bf16_t*)(ws + WS_W2IN), M, 2 * FF, D, E); }
    SEAM();
    if (EN(8)) { KA ka; unsigned char* ws = ka.ws(); EpiF32 E{(float*)(ws + WS_Y), D}; run_gemm(lds, (const bf16_t*)(ws + WS_H), (const bf16_t*)(ws + WS_W2OUT), M, D, FF, E); }
    SEAM();
    if (EN(9)) {
        { KA ka; unsigned char* ws = ka.ws(); const WaveId w = wave_id(); const float* g = ka.in(2) + (size_t)LAYER * 8 * D; float* xres = ka.out();
          rows_phase((const float*)(ws + WS_Y), 0.5f, g + 5 * D, g + 6 * D, xres, xres, (bf16_t*)(ws + WS_XN), w.gw, w.NGW, w.lane); }
        { KA ka; unsigned char* ws = ka.ws(); EpiBf E{(bf16_t*)(ws + WS_E), D}; run_gemm(lds, (const bf16_t*)(ws + WS_PB), (const bf16_t*)(ws + WS_WPROJ), M, D, PLE, E); }
    }
    SEAM();
    if (EN(10)) { KA ka; unsigned char* ws = ka.ws(); EpiGate E{(float*)(ws + WS_Y), (const bf16_t*)(ws + WS_E)}; run_gemm(lds, (const bf16_t*)(ws + WS_XN), (const bf16_t*)(ws + WS_WGATE), M, D, D, E); }
    SEAM();
    if (EN(11)) {
        { KA ka; unsigned char* ws = ka.ws(); const WaveId w = wave_id(); const float* g = ka.in(2) + (size_t)LAYER * 8 * D; float* xres = ka.out();
          rows_phase((const float*)(ws + WS_Y), 1.0f, g + 7 * D, (LAYER + 1 < DEPTH) ? g + 8 * D : nullptr, xres, xres, (bf16_t*)(ws + WS_XN), w.gw, w.NGW, w.lane); }
        if (LAYER + 1 < DEPTH) { KA ka; const WaveId w = wave_id(); LayerW L; layer_weights(ka, LAYER + 1, L); convert_weights(L, ka.ws(), (LAS float*)(lds + w.wave * 16384), w.gw, w.NGW, w.lane); }
    }
}

__global__ void __launch_bounds__(NWAVES * 64, 2) fwd_megakernel(Args args) {
    extern __shared__ __attribute__((aligned(16))) unsigned char lds_raw[];
    LAS unsigned char* lds = (LAS unsigned char*)lds_raw;
    cg::grid_group grid = cg::this_grid();
    if (threadIdx.x < 64) ((LAS unsigned*)(lds + 131072))[threadIdx.x] = 0u;
    __syncthreads();
    { KA ka; (void)xcd_barrier_post((unsigned*)(ka.ws() + WS_BAR), (volatile LAS unsigned*)(lds + MISC_OFF)); }
    {
        { KA ka; const WaveId w = wave_id(); LayerW L; layer_weights(ka, 0, L); convert_weights(L, ka.ws(), (LAS float*)(lds + w.wave * 16384), w.gw, w.NGW, w.lane); }
        { KA ka; const WaveId w = wave_id(); rows_phase(nullptr, 0.f, nullptr, ka.in(2), ka.in(0), ka.out(), (bf16_t*)(ka.ws() + WS_XN), w.gw, w.NGW, w.lane); }
    }
    grid.sync();
    layer_body<0>(lds, grid);
    SEAM();
    layer_body<1>(lds, grid);
}

extern "C" void kernel_launch(void* const* d_in, const int* in_sizes, int n_in, void* d_out, int out_size, void* d_ws, size_t ws_size, hipStream_t stream) {
    static int grid = 0;
    if (grid == 0) {
        if (n_in != 15 || in_sizes[0] != M * D || out_size != M * D || ws_size < WS_END) { fprintf(stderr, "kernel_launch: unexpected shapes (n_in %d, in0 %d, out %d, ws %zu)\n", n_in, n_in > 0 ? in_sizes[0] : -1, out_size, ws_size); grid = -1; return; }
        int dev = 0, cus = 0, per_cu = 0;
        if (hipGetDevice(&dev) != hipSuccess || hipDeviceGetAttribute(&cus, hipDeviceAttributeMultiprocessorCount, dev) != hipSuccess) { grid = -1; return; }
        if (hipFuncSetAttribute((const void*)fwd_megakernel, hipFuncAttributeMaxDynamicSharedMemorySize, LDS_BYTES) != hipSuccess) { fprintf(stderr, "kernel_launch: hipFuncSetAttribute failed\n"); grid = -1; return; }
        if (hipOccupancyMaxActiveBlocksPerMultiprocessor(&per_cu, (const void*)fwd_megakernel, NWAVES * 64, LDS_BYTES) != hipSuccess || per_cu < 1) { fprintf(stderr, "kernel_launch: occupancy query says %d\n", per_cu); per_cu = 1; }
        (void)hipGetLastError();
        grid = cus;
    }
    if (grid < 0) return;
    if (hipMemsetAsync(d_ws, 0, 1u << 20, stream) != hipSuccess) { fprintf(stderr, "kernel_launch: memset failed\n"); return; }
    Args a{};
    for (int i = 0; i < 15; ++i) a.in[i] = (const float*)d_in[i];
    a.out = (float*)d_out; a.ws = (unsigned char*)d_ws;
    void* kargs[] = {&a};
    hipError_t e = hipLaunchCooperativeKernel((const void*)fwd_megakernel, dim3(grid), dim3(NWAVES * 64), kargs, LDS_BYTES, stream);
    if (e != hipSuccess) fprintf(stderr, "kernel_launch: cooperative launch failed: %s (grid %d)\n", hipGetErrorString(e), grid);
}
```
